# Optimizing an MI355X kernel written in HIP

```python
import jax, jax.numpy as jnp
from jax import lax
import numpy as np


D_MODEL = 1024
BATCH = 2
SEQ = 8192
DEPTH = 1

GRID_W = 64
CTX_LEN = 256

D_MIX = D_MODEL
M_HEADS = 4
M_DH = 128
M_WIDTH = M_HEADS * M_DH
A_HEADS = 8
A_KV_HEADS = 2
A_DH = 64
A_GROUP = A_HEADS // A_KV_HEADS
A_WIDTH = A_HEADS * A_DH
A_KV_WIDTH = A_KV_HEADS * A_DH
WINDOW = 128
A_BLOCK = 128
CHUNK = 64
CONV_W = 5
D_FF = 2816
ROPE_BASE = 10000.0
N_MOD = 9
LN_EPS = 1e-5
FFN_RES = 0.5
ALPHA = (2.0 * DEPTH) ** 0.25
BETA = (8.0 * DEPTH) ** -0.25

OFF_QM = 0
OFF_KM = OFF_QM + M_WIDTH
OFF_VM = OFF_KM + M_WIDTH
OFF_OM = OFF_VM + M_WIDTH
OFF_G = OFF_OM + M_WIDTH
N_GATES = 4 * M_HEADS
OFF_QA = OFF_G + N_GATES
OFF_KA = OFF_QA + A_WIDTH
OFF_VA = OFF_KA + A_KV_WIDTH
N_IN = OFF_VA + A_KV_WIDTH

kernel_name = 'hybrid_mlstm_swa_macaron_dit_block'

F32 = jnp.float32


def _layer_norm(x, g, b):
    xf = x.astype(F32)
    mu = xf.mean(-1, keepdims=True)
    var = jnp.square(xf - mu).mean(-1, keepdims=True)
    return ((xf - mu) * lax.rsqrt(var + LN_EPS)).astype(x.dtype) * g + b


def _modulate(x, shift, scale):
    return x * (1.0 + scale) + shift


def _swiglu(h, w13, w2):
    a = h @ w13
    return (jax.nn.silu(a[..., :D_FF]) * a[..., D_FF:]) @ w2


def _ffn_sublayer(x, shift, scale, gate, w13, w2, g, b):
    y = _swiglu(_modulate(x, shift, scale), w13, w2)
    return _layer_norm(ALPHA * x + FFN_RES * gate * y, g, b)


def _centred_dwconv(x, w, b):
    T = x.shape[1]
    pad = CONV_W // 2
    xp = jnp.pad(x, ((0, 0), (pad, pad), (0, 0)))
    out = xp[:, 0:T] * w[0]
    for j in range(1, CONV_W):
        out = out + xp[:, j:j + T] * w[j]
    return out + b


def _axial_rope_tables(rows):
    row = jnp.repeat(jnp.arange(rows, dtype=F32), GRID_W)
    col = jnp.tile(jnp.arange(GRID_W, dtype=F32), rows)
    n_freq = A_DH // 4
    inv = ROPE_BASE ** (-jnp.arange(n_freq, dtype=F32) / n_freq)
    ang = jnp.concatenate([row[:, None] * inv, col[:, None] * inv], -1)
    return jnp.cos(ang), jnp.sin(ang)


def _rope(x, cos, sin):
    xf = x.astype(F32)
    half = A_DH // 2
    x1, x2 = xf[..., :half], xf[..., half:]
    cs = cos[None, :, None, :]
    sn = sin[None, :, None, :]
    return jnp.concatenate([x1 * cs - x2 * sn, x2 * cs + x1 * sn], -1).astype(x.dtype)


def _rev(a):
    return jnp.flip(a, axis=1)


def _mlstm_scan(q, k, v, li, lf, state, return_h):
    B, T, H, d = q.shape
    nc = T // CHUNK

    def to_chunks(a):
        a = a.reshape((B, nc, CHUNK) + a.shape[2:])
        return jnp.swapaxes(jnp.moveaxis(a, 1, 0), 2, 3)

    tril = jnp.tril(jnp.ones((CHUNK, CHUNK), dtype=bool))

    def body(carry, inp):
        C, nv, m = carry
        qc, kc, vc, lic, lfc = inp
        b = jnp.cumsum(lfc, axis=-1)
        b_last = b[..., -1]
        log_w = b_last[..., None] - b + lic
        m_new = jnp.maximum(b_last + m, log_w.max(-1))
        decay = jnp.exp(b_last + m - m_new)
        w = jnp.exp(log_w - m_new[..., None])
        C_new = decay[..., None, None] * C + jnp.einsum('bhs,bhsv,bhsk->bhvk', w, vc, kc)
        n_new = decay[..., None] * nv + jnp.einsum('bhs,bhsk->bhk', w, kc)
        if not return_h:
            return (C_new, n_new, m_new), None
        log_d = b[..., :, None] - b[..., None, :] + lic[..., None, :]
        log_d = jnp.where(tril, log_d, -jnp.inf)
        log_inter = b + m[..., None]
        m_t = jnp.maximum(log_inter, log_d.max(-1))
        dmat = jnp.exp(log_d - m_t[..., None])
        inter = jnp.exp(log_inter - m_t)
        s = jnp.einsum('bhtk,bhsk->bhts', qc, kc) * dmat
        num = jnp.einsum('bhts,bhsv->bhtv', s, vc) + inter[..., None] * jnp.einsum('bhtk,bhvk->bhtv', qc, C)
        den = s.sum(-1) + inter * jnp.einsum('bhtk,bhk->bht', qc, nv)
        h = num / jnp.maximum(jnp.abs(den), jnp.exp(-m_t))[..., None]
        return (C_new, n_new, m_new), h

    xs = (to_chunks(q), to_chunks(k), to_chunks(v), to_chunks(li), to_chunks(lf))
    state_out, hs = lax.scan(body, state, xs)
    if not return_h:
        return state_out, None
    h = jnp.moveaxis(jnp.swapaxes(hs, 2, 3), 0, 1).reshape(B, T, H, d)
    return state_out, h


def _bidir_mlstm(q, k, v, fwd, bwd, init_f, init_b, return_h):
    st_f, h_f = _mlstm_scan(q, k, v, fwd[0], fwd[1], init_f, return_h)
    st_b, h_b = _mlstm_scan(_rev(q), _rev(k), _rev(v), _rev(bwd[0]), _rev(bwd[1]), init_b, return_h)
    h = h_f + _rev(h_b) if return_h else None
    return h, st_f, st_b


def _mlstm_inputs(p, conv_w, conv_b, b_gates):
    B, T = p.shape[:2]
    qk = jax.nn.silu(_centred_dwconv(p[..., OFF_QM:OFF_VM], conv_w, conv_b))
    qk = qk.astype(F32).reshape(B, T, 2, M_HEADS, M_DH)
    q = qk[:, :, 0] * (M_DH ** -0.5)
    k = qk[:, :, 1]
    v = p[..., OFF_VM:OFF_OM].astype(F32).reshape(B, T, M_HEADS, M_DH)
    g = (p[..., OFF_G:OFF_QA] + b_gates).astype(F32).reshape(B, T, 4, M_HEADS)
    fwd = (g[:, :, 0], jax.nn.log_sigmoid(g[:, :, 1]))
    bwd = (g[:, :, 2], jax.nn.log_sigmoid(g[:, :, 3]))
    return q, k, v, fwd, bwd


def _mlstm_readout(h, o_pre, g):
    B, T = h.shape[:2]
    mu = h.mean(-1, keepdims=True)
    var = jnp.square(h - mu).mean(-1, keepdims=True)
    hn = ((h - mu) * lax.rsqrt(var + LN_EPS)).reshape(B, T, M_WIDTH)
    return (hn * g * jax.nn.sigmoid(o_pre.astype(F32))).astype(o_pre.dtype)


def _banded_attention(q, k, v, kc, vc, sink):
    B, n = q.shape[:2]
    nb = n // A_BLOCK
    scale = A_DH ** -0.5
    qb = q.reshape(B, nb, A_BLOCK, A_KV_HEADS, A_GROUP, A_DH)

    def band(a):
        ap = jnp.pad(a, ((0, 0), (A_BLOCK, A_BLOCK), (0, 0), (0, 0)))
        ap = ap.reshape(B, nb + 2, A_BLOCK, A_KV_HEADS, A_DH)
        return jnp.concatenate([ap[:, :-2], ap[:, 1:-1], ap[:, 2:]], axis=2)

    kb, vb = band(k), band(v)
    s_loc = jnp.einsum('bjikgd,bjrkd->bjkgir', qb, kb).astype(F32) * scale
    s_ctx = jnp.einsum('bjikgd,bckd->bjkgic', qb, kc).astype(F32) * scale
    i = jnp.arange(A_BLOCK)
    r = jnp.arange(3 * A_BLOCK)
    j = jnp.arange(nb)
    rel = r[None, :] - A_BLOCK - i[:, None]
    key_pos = (j[:, None] - 1) * A_BLOCK + r[None, :]
    valid = (jnp.abs(rel) <= WINDOW)[None] & ((key_pos >= 0) & (key_pos < n))[:, None, :]
    s_loc = jnp.where(valid[None, :, None, None], s_loc, -jnp.inf)
    sink_f = sink.astype(F32).reshape(1, 1, A_KV_HEADS, A_GROUP, 1)
    m = jnp.maximum(jnp.maximum(s_loc.max(-1), s_ctx.max(-1)), sink_f)
    e_loc = jnp.exp(s_loc - m[..., None])
    e_ctx = jnp.exp(s_ctx - m[..., None])
    den = e_loc.sum(-1) + e_ctx.sum(-1) + jnp.exp(sink_f - m)
    out = (jnp.einsum('bjkgir,bjrkd->bjkgid', e_loc, vb.astype(F32))
           + jnp.einsum('bjkgic,bckd->bjkgid', e_ctx, vc.astype(F32))) / den[..., None]
    return out.transpose(0, 1, 4, 2, 3, 5).reshape(B, n, A_WIDTH).astype(q.dtype)


def _context_attention(q, k, v, sink):
    B, Tc = q.shape[:2]
    qg = q.reshape(B, Tc, A_KV_HEADS, A_GROUP, A_DH)
    s = jnp.einsum('bikgd,bckd->bkgic', qg, k).astype(F32) * (A_DH ** -0.5)
    sink_b = jnp.broadcast_to(sink.astype(F32).reshape(1, A_KV_HEADS, A_GROUP, 1, 1), s.shape[:-1] + (1,))
    p = jax.nn.softmax(jnp.concatenate([s, sink_b], -1), axis=-1)[..., :-1]
    out = jnp.einsum('bkgic,bckd->bikgd', p.astype(v.dtype), v)
    return out.reshape(B, Tc, A_WIDTH)


def _token_mixer(h_lat, h_ctx, w_in, b_gates, conv_w, conv_b, mh_g, sink, w_out, cos, sin, need_ctx):
    B, n = h_lat.shape[:2]
    Tc = h_ctx.shape[1]
    p_l = h_lat @ w_in
    p_c = h_ctx @ w_in
    qc, kc, vc, fwd_c, bwd_c = _mlstm_inputs(p_c, conv_w, conv_b, b_gates)
    zero = (jnp.zeros((B, M_HEADS, M_DH, M_DH), F32), jnp.zeros((B, M_HEADS, M_DH), F32),
            jnp.zeros((B, M_HEADS), F32))
    hm_c, st_f, st_b = _bidir_mlstm(qc, kc, vc, fwd_c, bwd_c, zero, zero, need_ctx)
    ql, kl, vl, fwd_l, bwd_l = _mlstm_inputs(p_l, conv_w, conv_b, b_gates)
    hm_l, _, _ = _bidir_mlstm(ql, kl, vl, fwd_l, bwd_l, st_f, st_b, True)
    m_l = _mlstm_readout(hm_l, p_l[..., OFF_OM:OFF_G], mh_g)
    qa_l = _rope(p_l[..., OFF_QA:OFF_KA].reshape(B, n, A_HEADS, A_DH), cos, sin)
    ka_l = _rope(p_l[..., OFF_KA:OFF_VA].reshape(B, n, A_KV_HEADS, A_DH), cos, sin)
    va_l = p_l[..., OFF_VA:N_IN].reshape(B, n, A_KV_HEADS, A_DH)
    ka_c = p_c[..., OFF_KA:OFF_VA].reshape(B, Tc, A_KV_HEADS, A_DH)
    va_c = p_c[..., OFF_VA:N_IN].reshape(B, Tc, A_KV_HEADS, A_DH)
    a_l = _banded_attention(qa_l, ka_l, va_l, ka_c, va_c, sink)
    y_l = jnp.concatenate([m_l, a_l], -1) @ w_out
    if not need_ctx:
        return y_l, None
    m_c = _mlstm_readout(hm_c, p_c[..., OFF_OM:OFF_G], mh_g)
    qa_c = p_c[..., OFF_QA:OFF_KA].reshape(B, Tc, A_HEADS, A_DH)
    a_c = _context_attention(qa_c, ka_c, va_c, sink)
    y_c = jnp.concatenate([m_c, a_c], -1) @ w_out
    return y_l, y_c


def setup_inputs(seed: int = 0) -> dict:
    key = jax.random.key(seed)
    ks = jax.random.split(key, 24)

    def nrm(k, shape, scale):
        return jax.random.normal(k, shape, F32) * scale

    x = nrm(ks[0], (BATCH, SEQ, D_MODEL), 1.0)
    c = nrm(ks[1], (BATCH, D_MODEL), 1.0)
    ctx = nrm(ks[2], (BATCH, CTX_LEN, D_MODEL), 1.0)
    c_ctx = nrm(ks[3], (D_MODEL,), 1.0)
    w_ada = nrm(ks[4], (DEPTH, D_MODEL, N_MOD * D_MODEL), 0.5 * D_MODEL ** -0.5)
    b_ada = nrm(ks[5], (DEPTH, N_MOD * D_MODEL), 0.02)
    ln_g = 1.0 + nrm(ks[6], (DEPTH, 3, D_MODEL), 0.02)
    ln_b = nrm(ks[7], (DEPTH, 3, D_MODEL), 0.02)
    ffn_w13 = nrm(ks[8], (DEPTH, 2, D_MODEL, 2 * D_FF), D_MODEL ** -0.5)
    ffn_w2 = nrm(ks[9], (DEPTH, 2, D_FF, D_MODEL), BETA * D_FF ** -0.5)
    w_in = nrm(ks[10], (DEPTH, D_MODEL, N_IN), D_MODEL ** -0.5)
    f_bias = jnp.linspace(3.0, 6.0, M_HEADS, dtype=F32)[None, :]
    bi_f = nrm(ks[11], (DEPTH, M_HEADS), 0.1)
    bf_f = f_bias + nrm(ks[12], (DEPTH, M_HEADS), 0.1)
    bi_b = nrm(ks[13], (DEPTH, M_HEADS), 0.1)
    bf_b = f_bias + nrm(ks[14], (DEPTH, M_HEADS), 0.1)
    b_gates = jnp.concatenate([bi_f, bf_f, bi_b, bf_b], -1)
    conv_w = nrm(ks[15], (DEPTH, CONV_W, 2 * M_WIDTH), CONV_W ** -0.5)
    conv_b = nrm(ks[16], (DEPTH, 2 * M_WIDTH), 0.02)
    mh_norm_g = 1.0 + nrm(ks[17], (DEPTH, M_WIDTH), 0.02)
    attn_sink = nrm(ks[18], (DEPTH, A_HEADS), 0.5)
    w_out = nrm(ks[19], (DEPTH, D_MIX, D_MODEL), BETA * D_MIX ** -0.5)
    return {'x': x, 'c': c, 'ctx': ctx, 'c_ctx': c_ctx, 'w_ada': w_ada, 'b_ada': b_ada,
            'ln_g': ln_g, 'ln_b': ln_b, 'ffn_w13': ffn_w13, 'ffn_w2': ffn_w2, 'w_in': w_in,
            'b_gates': b_gates, 'conv_w': conv_w, 'conv_b': conv_b, 'mh_norm_g': mh_norm_g,
            'attn_sink': attn_sink, 'w_out': w_out}


def reference(x, c, ctx, c_ctx, w_ada, b_ada, ln_g, ln_b, ffn_w13, ffn_w2, w_in, b_gates,
              conv_w, conv_b, mh_norm_g, attn_sink, w_out):
    B, n, D = x.shape
    rows = n // GRID_W
    cos, sin = _axial_rope_tables(rows)
    x_lat, x_ctx = x, ctx
    for l in range(DEPTH):
        need_ctx = l < DEPTH - 1
        mod_l = (jax.nn.silu(c) @ w_ada[l] + b_ada[l]).reshape(B, N_MOD, 1, D)
        mod_c = (jax.nn.silu(c_ctx) @ w_ada[l] + b_ada[l]).reshape(N_MOD, 1, 1, D)
        ml = [mod_l[:, i] for i in range(N_MOD)]
        mc = [mod_c[i] for i in range(N_MOD)]
        x_lat = _ffn_sublayer(x_lat, ml[0], ml[1], ml[2], ffn_w13[l, 0], ffn_w2[l, 0], ln_g[l, 0], ln_b[l, 0])
        x_ctx = _ffn_sublayer(x_ctx, mc[0], mc[1], mc[2], ffn_w13[l, 0], ffn_w2[l, 0], ln_g[l, 0], ln_b[l, 0])
        y_lat, y_ctx = _token_mixer(_modulate(x_lat, ml[3], ml[4]), _modulate(x_ctx, mc[3], mc[4]),
                                    w_in[l], b_gates[l], conv_w[l], conv_b[l], mh_norm_g[l],
                                    attn_sink[l], w_out[l], cos, sin, need_ctx)
        x_lat = _layer_norm(ALPHA * x_lat + ml[5] * y_lat, ln_g[l, 1], ln_b[l, 1])
        x_lat = _ffn_sublayer(x_lat, ml[6], ml[7], ml[8], ffn_w13[l, 1], ffn_w2[l, 1], ln_g[l, 2], ln_b[l, 2])
        if need_ctx:
            x_ctx = _layer_norm(ALPHA * x_ctx + mc[5] * y_ctx, ln_g[l, 1], ln_b[l, 1])
            x_ctx = _ffn_sublayer(x_ctx, mc[6], mc[7], mc[8], ffn_w13[l, 1], ffn_w2[l, 1], ln_g[l, 2], ln_b[l, 2])
    return x_lat
```

```cpp
#include <hip/hip_runtime.h>
#include <hip/hip_cooperative_groups.h>
#include <cstdio>
#include <cstdint>
#include <cmath>
namespace cg = cooperative_groups;
namespace pg8 {
#define PG8_LAS __attribute__((address_space(3)))
typedef unsigned short bf16_t;
typedef short bf16x8 __attribute__((ext_vector_type(8)));
typedef float f32x4 __attribute__((ext_vector_type(4)));
typedef unsigned u32x4 __attribute__((ext_vector_type(4)));
constexpr int BM = 256, BK = 64, HALF = 128, HTB = HALF * BK * 2  , STAGE_BYTES = 8 * HTB, NXCD = 8, WGM = 8;

__host__ __device__ __forceinline__ int lds_byte(int r, int c) { const int st = (r >> 4) * 2 + (c >> 5), rr = r & 15, cc = c & 31, ob = rr * 64 + cc * 2; return st * 1024 + (ob ^ (((ob >> 9) & 1) << 5)); }
__host__ __device__ __forceinline__ void stage_rc(int b, int& R, int& C) { const int st = b / 1024, sb = b % 1024, swz = sb ^ (((sb >> 9) & 1) << 5); R = (st >> 1) * 16 + swz / 64; C = (st & 1) * 32 + (swz % 64) / 2; }
__host__ __device__ __forceinline__ int perm32(int rho) { const int n = rho >> 4, i = rho & 15; return 8 * (i >> 2) + 4 * n + (i & 3); }

struct Unit { int pm, pn; };
struct Gemm { const bf16_t* A; const bf16_t* Bt; int M, N, K; };

struct StaticOrder {
    int nM, nN, nwg, G, c;
    __host__ __device__ void init(int M, int N, int G_, int c_) { nM = M / BM; nN = N / BM; nwg = nM * nN; G = G_; c = c_; }
    __host__ __device__ bool next(int i, Unit& u) const {
        const long L = (long)i * G + c; if (L >= nwg) return false;
        int wgid = (int)L; { const int q = nwg / NXCD, r = nwg % NXCD, xcd = wgid % NXCD, off = wgid / NXCD; wgid = (xcd < r ? xcd * (q + 1) : r * (q + 1) + (xcd - r) * q) + off; }
        const int nig = WGM * nN, gid = wgid / nig, fm = gid * WGM, gsz = (nM - fm) < WGM ? (nM - fm) : WGM;
        u.pm = fm + ((wgid % nig) % gsz); u.pn = (wgid % nig) / gsz; return true;
    }
    __device__ __forceinline__ void a_ready(const Unit&) const {}
    __device__ __forceinline__ void done(const Unit&) const {}
};

__device__ __forceinline__ unsigned cvt_pk_bf16(float lo, float hi) { unsigned r; asm volatile("v_cvt_pk_bf16_f32 %0, %1, %2" : "=v"(r) : "v"(lo), "v"(hi)); return r; }
typedef float f32x2 __attribute__((ext_vector_type(2)));
__device__ __forceinline__ f32x2 gelu_pk(f32x2 v) {
    const f32x2 av = __builtin_elementwise_abs(v), d = av * 0.2316418882f + 1.0f;
    f32x2 t; t.x = __builtin_amdgcn_rcpf(d.x); t.y = __builtin_amdgcn_rcpf(d.y);
    f32x2 q = t * 0.5307027145f + (-0.7265760135f); q = q * t + 0.7107068705f; q = q * t + (-0.142248368f); q = q * t + 0.127414796f; q = q * t;
    const f32x2 s = (v * v) * (-0.72134752044f);
    f32x2 e; e.x = __builtin_amdgcn_exp2f(s.x); e.y = __builtin_amdgcn_exp2f(s.y);
    const f32x2 m = v * (q * e), r = v - m;
    f32x2 o; o.x = v.x < 0.f ? m.x : r.x; o.y = v.y < 0.f ? m.y : r.y; return o;
}

template <int ACT  > struct EpiBf16 {
    static constexpr bool PERM = true, AFTER_DRAIN = false; static_assert(ACT == 0 || ACT == 1, "EpiBf16: ACT is 0 (none) or 1 (gelu_pk)");
    bf16_t* O; int ldc; const float* bias; int split_cols; size_t split_stride; float scale0;
    __device__ __forceinline__ void operator()(const f32x4 (&acc)[2][2][4][2], const Unit& u, int wr, int wc, int fr, int fq) const {
        const int row0 = u.pm * BM + wr * 64 + fr; int colt = u.pn * BM; bf16_t* base = O;
        float sc = 1.f; if (split_cols) { const int t = colt / split_cols; base += (size_t)t * split_stride; colt -= t * split_cols; if (t == 0) sc = scale0; }
        const int col0 = colt + wc * 32 + 8 * fq, bcol0 = u.pn * BM + wc * 32 + 8 * fq;
        f32x4 bv[2][2];
#pragma unroll
        for (int bj = 0; bj < 2; ++bj)
#pragma unroll
            for (int n = 0; n < 2; ++n) bv[bj][n] = bias ? *(const f32x4*)(bias + bcol0 + bj * HALF + 4 * n) : (f32x4){0.f, 0.f, 0.f, 0.f};
#pragma unroll
        for (int ai = 0; ai < 2; ++ai)
#pragma unroll
            for (int m = 0; m < 4; ++m) { bf16_t* rowp = base + (size_t)(row0 + ai * HALF + m * 16) * ldc + col0;
#pragma unroll
                for (int bj = 0; bj < 2; ++bj) { f32x4 v0 = acc[ai][bj][m][0] + bv[bj][0], v1 = acc[ai][bj][m][1] + bv[bj][1];
                    if (ACT == 1) { f32x2 a = gelu_pk((f32x2){v0[0], v0[1]}), b = gelu_pk((f32x2){v0[2], v0[3]}), c = gelu_pk((f32x2){v1[0], v1[1]}), d = gelu_pk((f32x2){v1[2], v1[3]});
                        v0 = (f32x4){a.x, a.y, b.x, b.y}; v1 = (f32x4){c.x, c.y, d.x, d.y}; }
                    v0 = v0 * sc; v1 = v1 * sc; u32x4 w; w.x = cvt_pk_bf16(v0[0], v0[1]); w.y = cvt_pk_bf16(v0[2], v0[3]); w.z = cvt_pk_bf16(v1[0], v1[1]); w.w = cvt_pk_bf16(v1[2], v1[3]);
                    *(u32x4*)(rowp + bj * HALF) = w; } }
    }
};
__device__ __forceinline__ float silu_f(float x) { return x * __builtin_amdgcn_rcpf(1.0f + __builtin_amdgcn_exp2f(-1.4426950408889634f * x)); }
struct EpiSwiglu {
    static constexpr bool PERM = true, AFTER_DRAIN = false;
    bf16_t* O; int ldc;
    __device__ __forceinline__ void operator()(const f32x4 (&acc)[2][2][4][2], const Unit& u, int wr, int wc, int fr, int fq) const {
        const int row0 = u.pm * BM + wr * 64 + fr; const int col0 = u.pn * HALF + wc * 32 + 8 * fq;
#pragma unroll
        for (int ai = 0; ai < 2; ++ai)
#pragma unroll
            for (int m = 0; m < 4; ++m) {
                bf16_t* rowp = O + (size_t)(row0 + ai * HALF + m * 16) * ldc + col0;
                const f32x4 g0 = acc[ai][0][m][0], g1 = acc[ai][0][m][1], u0 = acc[ai][1][m][0], u1 = acc[ai][1][m][1];
                u32x4 w;
                w.x = cvt_pk_bf16(silu_f(g0[0]) * u0[0], silu_f(g0[1]) * u0[1]); w.y = cvt_pk_bf16(silu_f(g0[2]) * u0[2], silu_f(g0[3]) * u0[3]);
                w.z = cvt_pk_bf16(silu_f(g1[0]) * u1[0], silu_f(g1[1]) * u1[1]); w.w = cvt_pk_bf16(silu_f(g1[2]) * u1[2], silu_f(g1[3]) * u1[3]);
                *(u32x4*)rowp = w;
            }
    }
};
struct EpiRes {
    static constexpr bool PERM = false, AFTER_DRAIN = false;
    const float* src_lat; const float* src_ctx; float* dst_lat; float* dst_ctx; const float* mod; int gi; float coef; float alpha;
    __device__ __forceinline__ void operator()(const f32x4 (&acc)[2][2][4][2], const Unit& u, int wr, int wc, int fr, int fq) const {
        const int pm = u.pm; const bool isctx = pm >= 64;
        const float* sb = isctx ? src_ctx + (size_t)(pm - 64) * BM * 1024 : src_lat + (size_t)pm * BM * 1024;
        float* db = isctx ? dst_ctx + (size_t)(pm - 64) * BM * 1024 : dst_lat + (size_t)pm * BM * 1024;
        const int vb = isctx ? 2 : (pm >= 32 ? 1 : 0);
        const float* gv = mod + vb * 9216 + gi * 1024;
        const int rl0 = wr * 64 + fr, col0 = u.pn * BM + wc * 32 + 4 * fq;
#pragma unroll
        for (int bj = 0; bj < 2; ++bj)
#pragma unroll
            for (int n = 0; n < 2; ++n) {
                const int c = col0 + bj * HALF + n * 16;
                const f32x4 g = *(const f32x4*)(gv + c) * coef;
#pragma unroll
                for (int ai = 0; ai < 2; ++ai)
#pragma unroll
                    for (int m = 0; m < 4; ++m) {
                        const size_t off = (size_t)(rl0 + ai * HALF + m * 16) * 1024 + c;
                        const f32x4 xv = *(const f32x4*)(sb + off);
                        *(f32x4*)(db + off) = xv * alpha + g * acc[ai][bj][m][n];
                    }
            }
    }
};
template <class Epi, class Sched, bool ALIGN_EPI = false, bool SP2 = false>
__device__ __forceinline__ void gemm_phase(PG8_LAS unsigned char* lds, const Gemm g, const Sched& S, const Epi& E) {
    const int tid = threadIdx.x, wid = __builtin_amdgcn_readfirstlane(tid >> 6), lane = tid & 63, wr = wid >> 2, wc = wid & 3, fr = lane & 15, fq = lane >> 4;
    const int K = g.K, nt = K / BK;
    unsigned voffA[2], voffB[2];
#pragma unroll
    for (int i = 0; i < 2; ++i) { int R, C; stage_rc(tid * 16 + i * 8192, R, C); const int Rb = Epi::PERM ? ((R & ~31) + perm32(R & 31)) : R;
        voffA[i] = (unsigned)(R * K + C) * 2u; voffB[i] = (unsigned)(Rb * K + C) * 2u; }
    const size_t kstep = (size_t)(BK * 2);
    const size_t hstep = (size_t)HALF * K * 2;
    const size_t tstep = 2 * hstep;
    const unsigned ldsw = (unsigned)wid * 1024u;
    const int aoff = lds_byte(wr * 64 + fr, fq * 8), boff = lds_byte(wc * 32 + fr, fq * 8);
#define PG8_SA(b, h) (((b) * 2 + (h)) * HTB)
#define PG8_SB(b, h) ((4 + (b) * 2 + (h)) * HTB)
#define PG8_STAGE(bufoff, gbase, voff) do { _Pragma("unroll") for (int _i = 0; _i < 2; ++_i) \
        __builtin_amdgcn_global_load_lds((const unsigned*)((const char*)(gbase) + (voff)[_i]), (PG8_LAS unsigned*)(lds + (bufoff) + ldsw + _i * 8192), 16, 0, 0); } while (0)
#define PG8_LDA(dst, b, h) do { _Pragma("unroll") for (int m = 0; m < 4; ++m) _Pragma("unroll") for (int k = 0; k < 2; ++k) dst[m][k] = *(const PG8_LAS bf16x8*)(lds + PG8_SA(b, h) + aoff + m * 2048 + k * 1024); } while (0)
#define PG8_LDB(dst, b, h) do { _Pragma("unroll") for (int n = 0; n < 2; ++n) _Pragma("unroll") for (int k = 0; k < 2; ++k) dst[n][k] = *(const PG8_LAS bf16x8*)(lds + PG8_SB(b, h) + boff + n * 2048 + k * 1024); } while (0)
#define PG8_MMA(ai, bj, At, Bt) do { __builtin_amdgcn_s_setprio(1); _Pragma("unroll") for (int m = 0; m < 4; ++m) _Pragma("unroll") for (int n = 0; n < 2; ++n) _Pragma("unroll") for (int k = 0; k < 2; ++k) \
        acc[ai][bj][m][n] = __builtin_amdgcn_mfma_f32_16x16x32_bf16(Bt[n][k], At[m][k], acc[ai][bj][m][n], 0, 0, 0); __builtin_amdgcn_s_setprio(0); } while (0)
#define PG8_WAIT_V(n) asm volatile("s_waitcnt vmcnt(" #n ")" ::: "memory")
#define PG8_WAIT_L(n) asm volatile("s_waitcnt lgkmcnt(" #n ")" ::: "memory")
#define PG8_BAR __builtin_amdgcn_s_barrier()
#define PG8_SCHED __builtin_amdgcn_sched_barrier(0)
    Unit cur, nxt; int ui = 0;
    if (!S.next(0, cur)) return;
    f32x4 acc[2][2][4][2];
#pragma unroll
    for (int a = 0; a < 2; ++a)
#pragma unroll
        for (int b = 0; b < 2; ++b)
#pragma unroll
            for (int m = 0; m < 4; ++m)
#pragma unroll
                for (int n = 0; n < 2; ++n) acc[a][b][m][n] = (f32x4){0.f, 0.f, 0.f, 0.f};
    bf16x8 At[4][2], B0[2][2], B1[2][2];
    const char* cA = (const char*)g.A + (size_t)cur.pm * tstep; const char* cB = (const char*)g.Bt + (size_t)cur.pn * tstep;
    S.a_ready(cur);
    if constexpr (SP2) {
        PG8_STAGE(PG8_SB(0, 0), cB, voffB); PG8_STAGE(PG8_SB(0, 1), cB + hstep, voffB); PG8_STAGE(PG8_SA(0, 0), cA, voffA); PG8_STAGE(PG8_SA(0, 1), cA + hstep, voffA);
        if (wr == 1) PG8_BAR;
        PG8_WAIT_V(2); PG8_BAR;
        PG8_STAGE(PG8_SB(1, 0), cB + kstep, voffB); PG8_STAGE(PG8_SA(1, 0), cA + kstep, voffA); PG8_STAGE(PG8_SB(1, 1), cB + hstep + kstep, voffB);
        PG8_WAIT_V(6); PG8_BAR;
    } else {
        PG8_STAGE(PG8_SB(0, 0), cB, voffB); PG8_STAGE(PG8_SA(0, 0), cA, voffA); PG8_STAGE(PG8_SB(0, 1), cB + hstep, voffB); PG8_STAGE(PG8_SA(0, 1), cA + hstep, voffA);
        if (wr == 1) PG8_BAR;
        PG8_WAIT_V(4); PG8_BAR;
        PG8_STAGE(PG8_SB(1, 0), cB + kstep, voffB); PG8_STAGE(PG8_SA(1, 0), cA + kstep, voffA); PG8_STAGE(PG8_SB(1, 1), cB + hstep + kstep, voffB);
        PG8_WAIT_V(6); PG8_BAR;
    }
    for (;;) {
        const bool has_next = S.next(ui + 1, nxt);
        const char* nA = has_next ? (const char*)g.A + (size_t)nxt.pm * tstep : cA; const char* nB = has_next ? (const char*)g.Bt + (size_t)nxt.pn * tstep : cB;
        for (int t = 0; t < nt; t += 2) {
            const bool last = (t == nt - 2);
            const char* a1 = cA + (size_t)(t + 1) * kstep;
            const char* a2 = last ? nA : cA + (size_t)(t + 2) * kstep; const char* b2 = last ? nB : cB + (size_t)(t + 2) * kstep;
            const char* a3 = a2 + kstep; const char* b3 = b2 + kstep;
            if (last && has_next) S.a_ready(nxt);
            if constexpr (SP2) {
            PG8_LDB(B0, 0, 0); PG8_LDB(B1, 0, 1); PG8_SCHED; PG8_LDA(At, 0, 0); PG8_STAGE(PG8_SA(1, 1), a1 + hstep, voffA);
            PG8_WAIT_V(8); PG8_WAIT_L(0); PG8_BAR; PG8_MMA(0, 0, At, B0); PG8_MMA(0, 1, At, B1); PG8_BAR; PG8_SCHED;
            PG8_LDA(At, 0, 1); PG8_STAGE(PG8_SB(0, 0), b2, voffB); PG8_STAGE(PG8_SB(0, 1), b2 + hstep, voffB); PG8_STAGE(PG8_SA(0, 0), a2, voffA);
            PG8_WAIT_V(8); PG8_WAIT_L(0); PG8_BAR; PG8_MMA(1, 0, At, B0); PG8_MMA(1, 1, At, B1); PG8_BAR; PG8_SCHED;
            PG8_LDB(B0, 1, 0); PG8_LDB(B1, 1, 1); PG8_SCHED; PG8_LDA(At, 1, 0); PG8_STAGE(PG8_SA(0, 1), a2 + hstep, voffA);
            PG8_WAIT_V(8); PG8_WAIT_L(0); PG8_BAR; PG8_MMA(0, 0, At, B0); PG8_MMA(0, 1, At, B1); PG8_BAR; PG8_SCHED;
            PG8_LDA(At, 1, 1); PG8_STAGE(PG8_SB(1, 0), b3, voffB); PG8_STAGE(PG8_SB(1, 1), b3 + hstep, voffB); PG8_STAGE(PG8_SA(1, 0), a3, voffA);
            PG8_WAIT_V(8); PG8_WAIT_L(0); PG8_BAR; PG8_MMA(1, 0, At, B0); PG8_MMA(1, 1, At, B1); PG8_BAR; PG8_SCHED;
            } else {
            PG8_LDB(B0, 0, 0); PG8_SCHED; PG8_LDA(At, 0, 0); PG8_STAGE(PG8_SA(1, 1), a1 + hstep, voffA);
            PG8_WAIT_L(8); PG8_BAR; PG8_WAIT_L(0); PG8_MMA(0, 0, At, B0); PG8_BAR; PG8_SCHED;
            PG8_LDB(B1, 0, 1); PG8_STAGE(PG8_SB(0, 0), b2, voffB);
            PG8_BAR; PG8_WAIT_L(0); PG8_MMA(0, 1, At, B1); PG8_BAR;
            PG8_LDA(At, 0, 1); PG8_STAGE(PG8_SA(0, 0), a2, voffA);
            PG8_BAR; PG8_WAIT_L(0); PG8_MMA(1, 0, At, B0); PG8_BAR; PG8_SCHED;
            PG8_STAGE(PG8_SB(0, 1), b2 + hstep, voffB);
            PG8_WAIT_V(6); PG8_BAR; PG8_MMA(1, 1, At, B1); PG8_BAR;
            PG8_LDB(B0, 1, 0); PG8_SCHED; PG8_LDA(At, 1, 0); PG8_STAGE(PG8_SA(0, 1), a2 + hstep, voffA);
            PG8_WAIT_L(8); PG8_BAR; PG8_WAIT_L(0); PG8_MMA(0, 0, At, B0); PG8_BAR; PG8_SCHED;
            PG8_LDB(B1, 1, 1); PG8_STAGE(PG8_SB(1, 0), b3, voffB);
            PG8_BAR; PG8_WAIT_L(0); PG8_MMA(0, 1, At, B1); PG8_BAR;
            PG8_LDA(At, 1, 1); PG8_STAGE(PG8_SA(1, 0), a3, voffA);
            PG8_BAR; PG8_WAIT_L(0); PG8_MMA(1, 0, At, B0); PG8_BAR; PG8_SCHED;
            PG8_STAGE(PG8_SB(1, 1), b3 + hstep, voffB);
            PG8_WAIT_V(6); PG8_BAR; PG8_MMA(1, 1, At, B1); PG8_BAR;
            }
        }
        if constexpr (ALIGN_EPI) { if (wr == 0) PG8_BAR; }
        if constexpr (!Epi::AFTER_DRAIN) { E(acc, cur, wr, wc, fr, fq); S.done(cur); }
        if (!has_next) break;
#pragma unroll
        for (int a = 0; a < 2; ++a)
#pragma unroll
            for (int b = 0; b < 2; ++b)
#pragma unroll
                for (int m = 0; m < 4; ++m)
#pragma unroll
                    for (int n = 0; n < 2; ++n) acc[a][b][m][n] = (f32x4){0.f, 0.f, 0.f, 0.f};
        cur = nxt; cA = nA; cB = nB; ++ui;
        if constexpr (ALIGN_EPI) { if (wr == 1) PG8_BAR; }
    }
    PG8_WAIT_V(0);
    if constexpr (!ALIGN_EPI) { if (wr == 0) PG8_BAR; }
    PG8_BAR;
    if constexpr (Epi::AFTER_DRAIN) { E.fused(acc, cur, wr, wc, fr, fq, lds, wid, lane); S.done(cur); }
#undef PG8_SA
#undef PG8_SB
#undef PG8_STAGE
#undef PG8_LDA
#undef PG8_LDB
#undef PG8_MMA
#undef PG8_WAIT_V
#undef PG8_WAIT_L
#undef PG8_BAR
#undef PG8_SCHED
}
}
#define LAS __attribute__((address_space(3)))
typedef unsigned short bf16;
typedef unsigned v4u __attribute__((ext_vector_type(4)));
typedef unsigned v2u __attribute__((ext_vector_type(2)));
typedef float f32x4 __attribute__((ext_vector_type(4)));
typedef short bf16x8 __attribute__((ext_vector_type(8)));
typedef short bf16x4 __attribute__((ext_vector_type(4)));
#define LDS_WAIT() asm volatile("s_waitcnt lgkmcnt(0)" ::: "memory")

constexpr int NWAVES = 8;
constexpr int ML = 16384, MC = 512, MT = ML + MC, DM = 1024, DFF = 2816, NP = 2816, SEQ = 8192, CTXL = 256;
constexpr int COL_QM = 0, COL_KM = 512, COL_VM = 1024, COL_OM = 1536, COL_QA = 2048, COL_KA = 2560, COL_VA = 2688;
constexpr float LN_EPS = 1e-5f;
constexpr float ALPHA_RES = 1.189207115002721f;
constexpr float LOG2E = 1.4426950408889634f;
constexpr size_t MiB = 1u << 20;
constexpr size_t WS_MOD = 1 * MiB, WS_ROPE = 1 * MiB + 256 * 1024;
constexpr size_t WS_W13A = 2 * MiB, WS_W13B = 13 * MiB, WS_W2A = 24 * MiB, WS_W2B = 30 * MiB, WS_WIN = 36 * MiB, WS_WOUT = 42 * MiB;
constexpr size_t WS_XC = 44 * MiB, WS_GATES = 46 * MiB, WS_NU = 48 * MiB, WS_SC = 49 * MiB + 512 * 1024, WS_MS = 49 * MiB + 768 * 1024;
constexpr size_t WS_H = 50 * MiB, WS_P = 83 * MiB, WS_US = 174 * MiB, WS_END = 240 * MiB;
constexpr int LDS_BYTES = 147456;
constexpr int NUNIT_L = 1024, NUNIT = 1056;

struct Ctx {
    const float *x, *c, *ctx, *c_ctx, *w_ada, *b_ada, *ln_g, *ln_b, *w13, *w2, *w_in, *b_gates, *conv_w, *conv_b, *mh_g, *sink, *w_out;
    float* out; unsigned char* ws;
    float *MOD, *ROPE, *XC, *GATES, *NU, *SC, *MS;
    bf16 *W13A, *W13B, *W2A, *W2B, *WIN, *WOUT, *H, *P, *US;
    int tid, lane, wave, G, bx;
};

typedef float f32x2_t __attribute__((ext_vector_type(2))); typedef __bf16 bf16x2_t __attribute__((ext_vector_type(2)));
__device__ __forceinline__ unsigned pk2(float lo, float hi) { f32x2_t v = {lo, hi}; bf16x2_t b = __builtin_convertvector(v, bf16x2_t); return __builtin_bit_cast(unsigned, b); }
__device__ __forceinline__ float bflo(unsigned w) { return __uint_as_float(w << 16); }
__device__ __forceinline__ float bfhi(unsigned w) { return __uint_as_float(w & 0xffff0000u); }
__device__ __forceinline__ float bf1(unsigned short h) { return __uint_as_float((unsigned)h << 16); }
__device__ __forceinline__ float wave_sum(float v) {
#pragma unroll
    for (int o = 1; o < 64; o <<= 1) v += __shfl_xor(v, o);
    return v;
}
__device__ __forceinline__ float wave_max(float v) {
#pragma unroll
    for (int o = 1; o < 64; o <<= 1) v = fmaxf(v, __shfl_xor(v, o));
    return v;
}
__device__ __forceinline__ float logsig(float g) { return g >= 0.f ? -log1pf(__expf(-g)) : g - log1pf(__expf(g)); }
__device__ __forceinline__ float sigmoid_f(float x) { return __builtin_amdgcn_rcpf(1.0f + __builtin_amdgcn_exp2f(-LOG2E * x)); }

__device__ __forceinline__ void tr_item(const float* W, int srcN, int srcCol0, int k0, bf16* WT, int K, int dstRow0, LAS float* scr, int lane) {
#pragma unroll 8
    for (int i = 0; i < 32; ++i) { const int kk = 2 * i + (lane >> 5); scr[kk * 33 + (lane & 31)] = W[(size_t)(k0 + kk) * srcN + srcCol0 + (lane & 31)]; }
    LDS_WAIT(); asm volatile("" ::: "memory");
    const int c = lane & 7;
#pragma unroll
    for (int j = 0; j < 4; ++j) { const int n = (lane >> 3) + 8 * j; const LAS float* s = scr + (8 * c) * 33 + n;
        v4u o; o.x = pk2(s[0 * 33], s[1 * 33]); o.y = pk2(s[2 * 33], s[3 * 33]); o.z = pk2(s[4 * 33], s[5 * 33]); o.w = pk2(s[6 * 33], s[7 * 33]);
        *(v4u*)(WT + (size_t)(dstRow0 + n) * K + k0 + 8 * c) = o; }
    LDS_WAIT(); asm volatile("" ::: "memory");
}
__device__ __forceinline__ void p0_prologue(const Ctx& C, LAS unsigned char* lds) {
    const int tid = C.tid;
    {
        LAS float* sc = (LAS float*)lds; LAS float* part = sc + 3072;
        for (int i = tid; i < 3072; i += 512) { const int v = i >> 10, k = i & 1023; const float cv = v < 2 ? C.c[v * 1024 + k] : C.c_ctx[k]; sc[i] = cv / (1.0f + __expf(-cv)); }
        __syncthreads();
        for (int cb = C.bx; cb < 256; cb += C.G) {
            if (tid < 504) { const int jc = tid % 36, kg = tid / 36, j = 36 * cb + jc; float a0 = 0.f, a1 = 0.f, a2 = 0.f;
                for (int k = kg; k < 1024; k += 14) { const float w = C.w_ada[(size_t)k * 9216 + j]; a0 += sc[k] * w; a1 += sc[1024 + k] * w; a2 += sc[2048 + k] * w; }
                part[(kg * 3 + 0) * 36 + jc] = a0; part[(kg * 3 + 1) * 36 + jc] = a1; part[(kg * 3 + 2) * 36 + jc] = a2; }
            __syncthreads();
            if (tid < 108) { const int v = tid / 36, jc = tid % 36; float s = 0.f;
                for (int kg = 0; kg < 14; ++kg) s += part[(kg * 3 + v) * 36 + jc];
                C.MOD[v * 9216 + 36 * cb + jc] = s + C.b_ada[36 * cb + jc]; }
            __syncthreads();
        }
    }
    { const int gt = C.bx * 512 + tid; if (gt < 2048) { const int p = gt >> 4, f = gt & 15; const float inv = powf(10000.0f, -(float)f / 16.0f); const float ang = (float)p * inv;
        C.ROPE[2 * gt] = cosf(ang); C.ROPE[2 * gt + 1] = sinf(ang); } }
    LAS float* scr = (LAS float*)(lds + C.wave * 16384);
    const int gw = C.bx * NWAVES + C.wave, NGW = C.G * NWAVES;
    constexpr int I13 = 16 * 176, I2 = 44 * 32, IIN = 16 * 88, IOUT = 16 * 32, NITEMS = 2 * I13 + 2 * I2 + IIN + IOUT;
    for (int it = gw; it < NITEMS; it += NGW) {
        int r = it;
        if (r < 2 * I13) { const int l = r / I13, q = r % I13, kb = q / 176, nb = q % 176, c0 = 32 * nb;
            const int dst = c0 < DFF ? 256 * (c0 / 128) + (c0 % 128) : 256 * ((c0 - DFF) / 128) + 128 + ((c0 - DFF) % 128);
            tr_item(C.w13 + (size_t)l * 1024 * 5632, 5632, c0, 64 * kb, l ? C.W13B : C.W13A, 1024, dst, scr, C.lane); continue; }
        r -= 2 * I13;
        if (r < 2 * I2) { const int l = r / I2, q = r % I2, kb = q / 32, nb = q % 32;
            tr_item(C.w2 + (size_t)l * 2816 * 1024, 1024, 32 * nb, 64 * kb, l ? C.W2B : C.W2A, 2816, 32 * nb, scr, C.lane); continue; }
        r -= 2 * I2;
        if (r < IIN) { const int kb = r / 88, nb = r % 88, n0 = 32 * nb; const int src = n0 < 2048 ? n0 : n0 + 16;
            tr_item(C.w_in, 2832, src, 64 * kb, C.WIN, 1024, n0, scr, C.lane); continue; }
        r -= IIN;
        { const int kb = r / 32, nb = r % 32; tr_item(C.w_out, 1024, 32 * nb, 64 * kb, C.WOUT, 1024, 32 * nb, scr, C.lane); }
    }
}

__device__ __forceinline__ void p1_modulate(const Ctx& C) {
    const int gw = C.bx * NWAVES + C.wave, NGW = C.G * NWAVES, lane = C.lane;
    for (int r = gw; r < MT; r += NGW) {
        const float* src = r < ML ? C.x + (size_t)r * 1024 : C.ctx + (size_t)(r - ML) * 1024;
        const int vb = r < SEQ ? 0 : (r < ML ? 1 : 2); const float* mv = C.MOD + vb * 9216;
#pragma unroll
        for (int j = 0; j < 4; ++j) { const int c = 4 * lane + 256 * j; const f32x4 v = *(const f32x4*)(src + c), sh = *(const f32x4*)(mv + c), sc = *(const f32x4*)(mv + 1024 + c);
            const f32x4 h = v * (sc + 1.0f) + sh; v2u o; o.x = pk2(h.x, h.y); o.y = pk2(h.z, h.w); *(v2u*)(C.H + (size_t)r * 1024 + c) = o; }
    }
}

template <bool WRITE_H, bool GATES>
__device__ __forceinline__ void ln_phase(const Ctx& C, LAS unsigned char* lds, const float* src_lat, const float* src_ctx, float* dst_lat, float* dst_ctx, int nrows, int li, int shi, int sci) {
    const int gw = C.bx * NWAVES + C.wave, NGW = C.G * NWAVES, lane = C.lane;
    LAS float* WG = (LAS float*)lds;
    if (GATES) { for (int i = C.tid; i < 16384; i += 512) { const int k = i >> 4, gi = i & 15; WG[gi * 1024 + k] = C.w_in[(size_t)k * 2832 + 2048 + gi]; } __syncthreads(); }
    const float* lg = C.ln_g + li * 1024; const float* lb = C.ln_b + li * 1024;
    for (int r = gw; r < nrows; r += NGW) {
        const float* s = r < ML ? src_lat + (size_t)r * 1024 : src_ctx + (size_t)(r - ML) * 1024;
        float* d = r < ML ? dst_lat + (size_t)r * 1024 : dst_ctx + (size_t)(r - ML) * 1024;
        const int vb = r < SEQ ? 0 : (r < ML ? 1 : 2); const float* mv = C.MOD + vb * 9216;
        f32x4 v[4]; float sm = 0.f;
#pragma unroll
        for (int j = 0; j < 4; ++j) { v[j] = *(const f32x4*)(s + 4 * lane + 256 * j); sm += (v[j].x + v[j].y) + (v[j].z + v[j].w); }
        const float mean = wave_sum(sm) * (1.0f / 1024.0f); float s2 = 0.f;
#pragma unroll
        for (int j = 0; j < 4; ++j) { v[j] = v[j] - mean; s2 += (v[j].x * v[j].x + v[j].y * v[j].y) + (v[j].z * v[j].z + v[j].w * v[j].w); }
        const float rstd = 1.0f / sqrtf(wave_sum(s2) * (1.0f / 1024.0f) + LN_EPS);
        f32x4 hv[4];
#pragma unroll
        for (int j = 0; j < 4; ++j) { const int c = 4 * lane + 256 * j; const f32x4 g = *(const f32x4*)(lg + c), b = *(const f32x4*)(lb + c);
            const f32x4 xn = v[j] * rstd * g + b; *(f32x4*)(d + c) = xn;
            if (WRITE_H) { const f32x4 sh = *(const f32x4*)(mv + shi * 1024 + c), sc = *(const f32x4*)(mv + sci * 1024 + c); const f32x4 h = xn * (sc + 1.0f) + sh; hv[j] = h;
                v2u o; o.x = pk2(h.x, h.y); o.y = pk2(h.z, h.w); *(v2u*)(C.H + (size_t)r * 1024 + c) = o; } }
        if (GATES) {
#pragma unroll 4
            for (int gi = 0; gi < 16; ++gi) { float a = 0.f;
#pragma unroll
                for (int j = 0; j < 4; ++j) { const f32x4 w = *(const LAS f32x4*)(WG + gi * 1024 + 4 * lane + 256 * j); a += (hv[j].x * w.x + hv[j].y * w.y) + (hv[j].z * w.z + hv[j].w * w.w); }
                a = wave_sum(a); if (lane == 0) C.GATES[(size_t)r * 16 + gi] = a + C.b_gates[gi]; }
        }
    }
    if (GATES) __syncthreads();
}

__device__ __forceinline__ void conv8(const bf16* P, size_t seqrow0, int T, int tpos, int col, const float* conv_w, const float* conv_b, int cch, float (&o)[8]) {
    const f32x4 b0 = *(const f32x4*)(conv_b + cch), b1 = *(const f32x4*)(conv_b + cch + 4);
    float a[8] = {b0.x, b0.y, b0.z, b0.w, b1.x, b1.y, b1.z, b1.w};
#pragma unroll
    for (int j = 0; j < 5; ++j) { const int tp = tpos + j - 2;
        if (tp >= 0 && tp < T) { const v4u raw = *(const v4u*)(P + (seqrow0 + tp) * NP + col);
            const f32x4 w0 = *(const f32x4*)(conv_w + j * 1024 + cch), w1 = *(const f32x4*)(conv_w + j * 1024 + cch + 4);
            a[0] += bflo(raw.x) * w0.x; a[1] += bfhi(raw.x) * w0.y; a[2] += bflo(raw.y) * w0.z; a[3] += bfhi(raw.y) * w0.w;
            a[4] += bflo(raw.z) * w1.x; a[5] += bfhi(raw.z) * w1.y; a[6] += bflo(raw.w) * w1.z; a[7] += bfhi(raw.w) * w1.w; } }
#pragma unroll
    for (int e = 0; e < 8; ++e) o[e] = a[e] * sigmoid_f(a[e]);
}
__device__ __forceinline__ float pre_sum(float v, int lane) {
#pragma unroll
    for (int o = 1; o < 64; o <<= 1) { const float t = __shfl_up(v, o); if (lane >= o) v += t; }
    return v;
}
__device__ __forceinline__ float suf_sum(float v, int lane) {
#pragma unroll
    for (int o = 1; o < 64; o <<= 1) { const float t = __shfl_down(v, o); if (lane + o < 64) v += t; }
    return v;
}
__device__ __forceinline__ float pre_max(float v, int lane) {
#pragma unroll
    for (int o = 1; o < 64; o <<= 1) { const float t = __shfl_up(v, o); if (lane >= o) v = fmaxf(v, t); }
    return v;
}
__device__ __forceinline__ float suf_max(float v, int lane) {
#pragma unroll
    for (int o = 1; o < 64; o <<= 1) { const float t = __shfl_down(v, o); if (lane + o < 64) v = fmaxf(v, t); }
    return v;
}
__device__ __forceinline__ void unit_decode(int u, int& b, int& h, int& c, size_t& seqrow0, int& T) {
    if (u < NUNIT_L) { b = u >> 9; h = (u >> 7) & 3; c = u & 127; seqrow0 = (size_t)b * SEQ; T = SEQ; }
    else { const int uu = u - NUNIT_L; b = uu >> 4; h = (uu >> 2) & 3; c = uu & 3; seqrow0 = (size_t)ML + (size_t)b * CTXL; T = CTXL; }
}

__device__ __forceinline__ void mlstm_local_unit(const Ctx& C, LAS unsigned char* lds, int u) {
    const int tid = C.tid, lane = C.lane, wid = C.wave, fr = lane & 15, fq = lane >> 4;
    int b, h, c, T; size_t seqrow0; unit_decode(u, b, h, c, seqrow0, T);
    const int t0 = 64 * c; const size_t r0 = seqrow0 + t0;
    LAS bf16* KT = (LAS bf16*)lds;
    LAS bf16* VTf = (LAS bf16*)(lds + 18432);
    LAS bf16* VTb = (LAS bf16*)(lds + 36864);
    LAS float* wf = (LAS float*)(lds + 55296);
    LAS float* wb = wf + 64;
    if (wid == 0) {
        const float* G = C.GATES + (r0 + lane) * 16;
        const float li_f = G[h], lf_f = logsig(G[4 + h]), li_b = G[8 + h], lf_b = logsig(G[12 + h]);
        const float b_f = pre_sum(lf_f, lane), b_b = suf_sum(lf_b, lane);
        const float Bf = __shfl(b_f, 63), Bb = __shfl(b_b, 0);
        const float lwf = Bf - b_f + li_f, lwb = Bb - b_b + li_b;
        const float af = wave_max(lwf), ab = wave_max(lwb);
        wf[lane] = __expf(lwf - af); wb[lane] = __expf(lwb - ab);
        if (lane == 0) { C.SC[(u * 2 + 0) * 2 + 0] = Bf; C.SC[(u * 2 + 0) * 2 + 1] = af; C.SC[(u * 2 + 1) * 2 + 0] = Bb; C.SC[(u * 2 + 1) * 2 + 1] = ab; }
    }
    const int chg = tid & 15, tt = tid >> 4;
#pragma unroll
    for (int q = 0; q < 2; ++q) { const int t = tt + 32 * q; float o[8];
        conv8(C.P, seqrow0, T, t0 + t, COL_KM + h * 128 + 8 * chg, C.conv_w, C.conv_b, 512 + h * 128 + 8 * chg, o);
#pragma unroll
        for (int e = 0; e < 8; ++e) KT[(8 * chg + e) * 72 + t] = (bf16)(pk2(o[e], 0.f) & 0xffffu); }
    __syncthreads();
#pragma unroll
    for (int q = 0; q < 2; ++q) { const int t = tt + 32 * q; const v4u raw = *(const v4u*)(C.P + (r0 + t) * NP + COL_VM + h * 128 + 8 * chg);
        const float a = wf[t], bw = wb[t];
        const float v[8] = {bflo(raw.x), bfhi(raw.x), bflo(raw.y), bfhi(raw.y), bflo(raw.z), bfhi(raw.z), bflo(raw.w), bfhi(raw.w)};
#pragma unroll
        for (int e = 0; e < 8; ++e) { VTf[(8 * chg + e) * 72 + t] = (bf16)(pk2(v[e] * a, 0.f) & 0xffffu); VTb[(8 * chg + e) * 72 + t] = (bf16)(pk2(v[e] * bw, 0.f) & 0xffffu); } }
    __syncthreads();
#pragma unroll
    for (int dir = 0; dir < 2; ++dir) { const LAS bf16* VTx = dir ? VTb : VTf;
        const bf16x8 vb0 = *(const LAS bf16x8*)(VTx + (16 * wid + fr) * 72 + 8 * fq), vb1 = *(const LAS bf16x8*)(VTx + (16 * wid + fr) * 72 + 32 + 8 * fq);
        bf16* Ud = C.US + ((size_t)(u * 2 + dir) * 16384) + (16 * wid + fr) * 128 + 4 * fq;
#pragma unroll
        for (int kt = 0; kt < 8; ++kt) { const bf16x8 ka0 = *(const LAS bf16x8*)(KT + (16 * kt + fr) * 72 + 8 * fq), ka1 = *(const LAS bf16x8*)(KT + (16 * kt + fr) * 72 + 32 + 8 * fq);
            f32x4 acc = {0.f, 0.f, 0.f, 0.f};
            acc = __builtin_amdgcn_mfma_f32_16x16x32_bf16(ka0, vb0, acc, 0, 0, 0); acc = __builtin_amdgcn_mfma_f32_16x16x32_bf16(ka1, vb1, acc, 0, 0, 0);
            v2u o; o.x = pk2(acc[0], acc[1]); o.y = pk2(acc[2], acc[3]); *(v2u*)(Ud + 16 * kt) = o; } }
    if (tid < 256) { const int k = tid & 127, dir = tid >> 7; const LAS float* w = dir ? wb : wf; float s = 0.f;
#pragma unroll 8
        for (int t = 0; t < 64; ++t) s += w[t] * bf1(KT[k * 72 + t]);
        C.NU[(size_t)(u * 2 + dir) * 128 + k] = s; }
    __syncthreads();
}

__device__ __forceinline__ int chain_unit(int bh, int dir, int i) {
    if (i < 4) return NUNIT_L + bh * 4 + (dir ? 3 - i : i);
    return bh * 128 + (dir ? 127 - (i - 4) : (i - 4));
}
template <bool ISN> __device__ __forceinline__ f32x4 scan_ld(const Ctx& C, int ud, int eoff) {
    if (ISN) return *(const f32x4*)(C.NU + (size_t)ud * 128 + eoff);
    const v2u raw = *(const v2u*)(C.US + (size_t)ud * 16384 + eoff); return (f32x4){bflo(raw.x), bfhi(raw.x), bflo(raw.y), bfhi(raw.y)};
}
template <bool ISN> __device__ __forceinline__ void scan_st(const Ctx& C, int ud, int eoff, f32x4 v) {
    if (ISN) { *(f32x4*)(C.NU + (size_t)ud * 128 + eoff) = v; }
    else { v2u w; w.x = pk2(v.x, v.y); w.y = pk2(v.z, v.w); *(v2u*)(C.US + (size_t)ud * 16384 + eoff) = w; }
}
template <bool ISN> __device__ __forceinline__ void scan_chain(const Ctx& C, int bh, int dir, int eoff) {
    float m = 0.f; f32x4 st = {0.f, 0.f, 0.f, 0.f};
    f32x4 c4[4];
#pragma unroll
    for (int i = 0; i < 4; ++i) c4[i] = scan_ld<ISN>(C, chain_unit(bh, dir, i) * 2 + dir, eoff);
    f32x4 nx[8];
#pragma unroll
    for (int q = 0; q < 8; ++q) nx[q] = scan_ld<ISN>(C, chain_unit(bh, dir, 4 + q) * 2 + dir, eoff);
#pragma unroll
    for (int i = 0; i < 4; ++i) { const int ud = chain_unit(bh, dir, i) * 2 + dir; const float Bt = C.SC[ud * 2], a = C.SC[ud * 2 + 1];
        const float mn = fmaxf(Bt + m, a), d1 = __expf(Bt + m - mn), d2 = __expf(a - mn); st = st * d1 + c4[i] * d2; m = mn; }
    for (int i0 = 4; i0 < 132; i0 += 8) {
        f32x4 cur[8];
#pragma unroll
        for (int q = 0; q < 8; ++q) cur[q] = nx[q];
        if (i0 + 8 < 132) {
#pragma unroll
            for (int q = 0; q < 8; ++q) nx[q] = scan_ld<ISN>(C, chain_unit(bh, dir, i0 + 8 + q) * 2 + dir, eoff);
        }
#pragma unroll
        for (int q = 0; q < 8; ++q) { const int ud = chain_unit(bh, dir, i0 + q) * 2 + dir; const float Bt = C.SC[ud * 2], a = C.SC[ud * 2 + 1];
            scan_st<ISN>(C, ud, eoff, st);
            if (ISN && eoff == 0) C.MS[ud] = m;
            const float mn = fmaxf(Bt + m, a), d1 = __expf(Bt + m - mn), d2 = __expf(a - mn); st = st * d1 + cur[q] * d2; m = mn; }
    }
}
__device__ __forceinline__ void p7_scan(const Ctx& C) {
    const int tid = C.tid;
    if (C.bx < 128) { const int g = C.bx * 512 + tid, ch = g >> 12, e4 = g & 4095; scan_chain<false>(C, ch >> 1, ch & 1, 4 * e4); }
    else if (C.bx == 128) { const int ch = tid >> 5, k4 = tid & 31; scan_chain<true>(C, ch >> 1, ch & 1, 4 * k4); }
}

__device__ __forceinline__ void mlstm_out_unit(const Ctx& C, LAS unsigned char* lds, int u) {
    const int tid = C.tid, lane = C.lane, wid = C.wave, fr = lane & 15, fq = lane >> 4;
    const int b = u >> 9, h = (u >> 7) & 3, c = u & 127; const size_t seqrow0 = (size_t)b * SEQ; const int t0 = 64 * c; const size_t r0 = seqrow0 + t0;
    LAS bf16* Qs = (LAS bf16*)lds;
    LAS bf16* Ks = (LAS bf16*)(lds + 17408);
    LAS bf16* VT = (LAS bf16*)(lds + 34816);
    LAS bf16* Cs = (LAS bf16*)(lds + 53248);
    LAS bf16* Ss = (LAS bf16*)(lds + 88064);
    LAS float* Hs = (LAS float*)(lds + 97280);
    LAS float* sm = (LAS float*)(lds + 131072);
    LAS float* gA = sm;
    LAS float* MA = sm + 128;
    LAS float* IA = sm + 256;
    LAS float* FA = sm + 384;
    LAS float* DP = sm + 512;
    LAS float* DN = sm + 640;
    LAS float* NS = sm + 704;
    if (wid == 0) {
        const float* G = C.GATES + (r0 + lane) * 16;
        const float li_f = G[h], lf_f = logsig(G[4 + h]), li_b = G[8 + h], lf_b = logsig(G[12 + h]);
        const float b_f = pre_sum(lf_f, lane), b_b = suf_sum(lf_b, lane);
        const float g_f = li_f - b_f, g_b = li_b - b_b;
        const float m_f = C.MS[u * 2 + 0], m_b = C.MS[u * 2 + 1];
        const float M_f = fmaxf(m_f, pre_max(g_f, lane)), M_b = fmaxf(m_b, suf_max(g_b, lane));
        gA[lane] = g_f; gA[64 + lane] = g_b; MA[lane] = M_f; MA[64 + lane] = M_b;
        IA[lane] = __expf(m_f - M_f); IA[64 + lane] = __expf(m_b - M_b);
        FA[lane] = __expf(-(b_f + M_f)); FA[64 + lane] = __expf(-(b_b + M_b));
    }
    const int chg = tid & 15, tt = tid >> 4;
#pragma unroll
    for (int q = 0; q < 2; ++q) { const int t = tt + 32 * q; float o[8];
        conv8(C.P, seqrow0, SEQ, t0 + t, COL_QM + h * 128 + 8 * chg, C.conv_w, C.conv_b, h * 128 + 8 * chg, o);
        const float qs = 0.08838834764831845f;
        v4u w; w.x = pk2(o[0] * qs, o[1] * qs); w.y = pk2(o[2] * qs, o[3] * qs); w.z = pk2(o[4] * qs, o[5] * qs); w.w = pk2(o[6] * qs, o[7] * qs);
        *(LAS v4u*)(Qs + t * 136 + 8 * chg) = w;
        conv8(C.P, seqrow0, SEQ, t0 + t, COL_KM + h * 128 + 8 * chg, C.conv_w, C.conv_b, 512 + h * 128 + 8 * chg, o);
        w.x = pk2(o[0], o[1]); w.y = pk2(o[2], o[3]); w.z = pk2(o[4], o[5]); w.w = pk2(o[6], o[7]);
        *(LAS v4u*)(Ks + t * 136 + 8 * chg) = w;
        const v4u raw = *(const v4u*)(C.P + (r0 + t) * NP + COL_VM + h * 128 + 8 * chg);
        VT[(8 * chg + 0) * 72 + t] = (bf16)(raw.x & 0xffffu); VT[(8 * chg + 1) * 72 + t] = (bf16)(raw.x >> 16);
        VT[(8 * chg + 2) * 72 + t] = (bf16)(raw.y & 0xffffu); VT[(8 * chg + 3) * 72 + t] = (bf16)(raw.y >> 16);
        VT[(8 * chg + 4) * 72 + t] = (bf16)(raw.z & 0xffffu); VT[(8 * chg + 5) * 72 + t] = (bf16)(raw.z >> 16);
        VT[(8 * chg + 6) * 72 + t] = (bf16)(raw.w & 0xffffu); VT[(8 * chg + 7) * 72 + t] = (bf16)(raw.w >> 16); }
    __syncthreads();
    const int tm = wid & 3, sh = wid >> 2;
    f32x4 S[2];
#pragma unroll
    for (int st = 0; st < 2; ++st) { f32x4 acc = {0.f, 0.f, 0.f, 0.f};
#pragma unroll
        for (int ks = 0; ks < 4; ++ks) { const bf16x8 a = *(const LAS bf16x8*)(Qs + (16 * tm + fr) * 136 + 32 * ks + 8 * fq), bb = *(const LAS bf16x8*)(Ks + (32 * sh + 16 * st + fr) * 136 + 32 * ks + 8 * fq);
            acc = __builtin_amdgcn_mfma_f32_16x16x32_bf16(a, bb, acc, 0, 0, 0); }
        S[st] = acc; }
    const int vh = wid >> 2;
    f32x4 hacc[4];
#pragma unroll
    for (int vt = 0; vt < 4; ++vt) hacc[vt] = (f32x4){0.f, 0.f, 0.f, 0.f};
    for (int dir = 0; dir < 2; ++dir) {
        { const bf16* src = C.US + (size_t)(u * 2 + dir) * 16384;
#pragma unroll
            for (int q = 0; q < 4; ++q) { const int idx = tid + 512 * q; const int v = idx >> 4, k8 = idx & 15; *(LAS v4u*)(Cs + v * 136 + 8 * k8) = *(const v4u*)(src + v * 128 + 8 * k8); }
            if (tid < 128) NS[tid] = C.NU[(size_t)(u * 2 + dir) * 128 + tid]; }
        { float rs[4] = {0.f, 0.f, 0.f, 0.f};
#pragma unroll
            for (int st = 0; st < 2; ++st) { const int s = 32 * sh + 16 * st + fr; const float gs = gA[dir * 64 + s];
#pragma unroll
                for (int i = 0; i < 4; ++i) { const int t = 16 * tm + 4 * fq + i; const bool ok = dir ? (s >= t) : (s <= t);
                    const float val = ok ? S[st][i] * __expf(gs - MA[dir * 64 + t]) : 0.f; rs[i] += val; Ss[t * 72 + s] = (bf16)(pk2(val, 0.f) & 0xffffu); } }
#pragma unroll
            for (int i = 0; i < 4; ++i) { float r = rs[i]; r += __shfl_xor(r, 1); r += __shfl_xor(r, 2); r += __shfl_xor(r, 4); r += __shfl_xor(r, 8); if (fr == 0) DP[sh * 64 + 16 * tm + 4 * fq + i] = r; } }
        __syncthreads();
        f32x4 accA[4], accB[4];
#pragma unroll
        for (int vt = 0; vt < 4; ++vt) { accA[vt] = (f32x4){0.f, 0.f, 0.f, 0.f}; accB[vt] = (f32x4){0.f, 0.f, 0.f, 0.f}; }
#pragma unroll
        for (int ks = 0; ks < 2; ++ks) { const bf16x8 a = *(const LAS bf16x8*)(Ss + (16 * tm + fr) * 72 + 32 * ks + 8 * fq);
#pragma unroll
            for (int vt = 0; vt < 4; ++vt) { const bf16x8 bb = *(const LAS bf16x8*)(VT + (64 * vh + 16 * vt + fr) * 72 + 32 * ks + 8 * fq); accA[vt] = __builtin_amdgcn_mfma_f32_16x16x32_bf16(a, bb, accA[vt], 0, 0, 0); } }
#pragma unroll
        for (int ks = 0; ks < 4; ++ks) { const bf16x8 a = *(const LAS bf16x8*)(Qs + (16 * tm + fr) * 136 + 32 * ks + 8 * fq);
#pragma unroll
            for (int vt = 0; vt < 4; ++vt) { const bf16x8 bb = *(const LAS bf16x8*)(Cs + (64 * vh + 16 * vt + fr) * 136 + 32 * ks + 8 * fq); accB[vt] = __builtin_amdgcn_mfma_f32_16x16x32_bf16(a, bb, accB[vt], 0, 0, 0); } }
        { const int t = tid >> 3, part = tid & 7; float d = 0.f;
#pragma unroll
            for (int e = 0; e < 16; ++e) d += bf1(Qs[t * 136 + 16 * part + e]) * NS[16 * part + e];
            d += __shfl_xor(d, 1); d += __shfl_xor(d, 2); d += __shfl_xor(d, 4);
            if (part == 0) { const float den = DP[t] + DP[64 + t] + IA[dir * 64 + t] * d; DN[t] = 1.0f / fmaxf(fabsf(den), FA[dir * 64 + t]); } }
        __syncthreads();
#pragma unroll
        for (int i = 0; i < 4; ++i) { const int t = 16 * tm + 4 * fq + i; const float it = IA[dir * 64 + t], dn = DN[t];
#pragma unroll
            for (int vt = 0; vt < 4; ++vt) hacc[vt][i] += (accA[vt][i] + it * accB[vt][i]) * dn; }
        __syncthreads();
    }
#pragma unroll
    for (int vt = 0; vt < 4; ++vt)
#pragma unroll
        for (int i = 0; i < 4; ++i) Hs[(16 * tm + 4 * fq + i) * 132 + 64 * vh + 16 * vt + fr] = hacc[vt][i];
    __syncthreads();
    { const int t = tid >> 3, part = tid & 7; float hv[16]; float s = 0.f;
#pragma unroll
        for (int e = 0; e < 16; ++e) { hv[e] = Hs[t * 132 + 16 * part + e]; s += hv[e]; }
        s += __shfl_xor(s, 1); s += __shfl_xor(s, 2); s += __shfl_xor(s, 4);
        const float mu = s * (1.0f / 128.0f); float q = 0.f;
#pragma unroll
        for (int e = 0; e < 16; ++e) { hv[e] -= mu; q += hv[e] * hv[e]; }
        q += __shfl_xor(q, 1); q += __shfl_xor(q, 2); q += __shfl_xor(q, 4);
        const float rstd = 1.0f / sqrtf(q * (1.0f / 128.0f) + LN_EPS);
        const bf16* op = C.P + (r0 + t) * NP + COL_OM + h * 128 + 16 * part; const float* gp = C.mh_g + h * 128 + 16 * part;
        const v4u o0 = *(const v4u*)op, o1 = *(const v4u*)(op + 8);
        const float ov[16] = {bflo(o0.x), bfhi(o0.x), bflo(o0.y), bfhi(o0.y), bflo(o0.z), bfhi(o0.z), bflo(o0.w), bfhi(o0.w), bflo(o1.x), bfhi(o1.x), bflo(o1.y), bfhi(o1.y), bflo(o1.z), bfhi(o1.z), bflo(o1.w), bfhi(o1.w)};
        float r[16];
#pragma unroll
        for (int e = 0; e < 16; ++e) r[e] = hv[e] * rstd * gp[e] * sigmoid_f(ov[e]);
        v4u w0, w1; w0.x = pk2(r[0], r[1]); w0.y = pk2(r[2], r[3]); w0.z = pk2(r[4], r[5]); w0.w = pk2(r[6], r[7]); w1.x = pk2(r[8], r[9]); w1.y = pk2(r[10], r[11]); w1.z = pk2(r[12], r[13]); w1.w = pk2(r[14], r[15]);
        bf16* dst = C.H + (r0 + t) * 1024 + h * 128 + 16 * part; *(v4u*)dst = w0; *(v4u*)(dst + 8) = w1; }
    __syncthreads();
}

template <bool MASKED>
__device__ __forceinline__ void attn_chunk(const LAS bf16* Kb  , const LAS bf16* VTb  , int vpitch, const bf16x8 (&qf)[4][2],
                                           f32x4 (&O)[4][4], float (&m)[4], float (&l)[4], int fr, int fq, int rr0  , int iq0  , int pos0  ) {
#pragma unroll
    for (int qt = 0; qt < 4; ++qt) {
        f32x4 S[4];
#pragma unroll
        for (int kt = 0; kt < 4; ++kt) { const bf16x8 kf0 = *(const LAS bf16x8*)(Kb + (16 * kt + fr) * 72 + 8 * fq), kf1 = *(const LAS bf16x8*)(Kb + (16 * kt + fr) * 72 + 32 + 8 * fq);
            f32x4 a = {0.f, 0.f, 0.f, 0.f};
            a = __builtin_amdgcn_mfma_f32_16x16x32_bf16(kf0, qf[qt][0], a, 0, 0, 0); a = __builtin_amdgcn_mfma_f32_16x16x32_bf16(kf1, qf[qt][1], a, 0, 0, 0); S[kt] = a; }
        if (MASKED) {
#pragma unroll
            for (int kt = 0; kt < 4; ++kt)
#pragma unroll
                for (int i = 0; i < 4; ++i) { const int rr = rr0 + 16 * kt + 4 * fq + i, iq = iq0 + 16 * qt, rel = rr - 128 - iq, pos = pos0 + rr;
                    const bool ok = rel >= -128 && rel <= 128 && pos >= 0 && pos < SEQ; if (!ok) S[kt][i] = -INFINITY; }
        }
        float mx = fmaxf(fmaxf(S[0][0], S[0][1]), fmaxf(S[0][2], S[0][3]));
#pragma unroll
        for (int kt = 1; kt < 4; ++kt) mx = fmaxf(mx, fmaxf(fmaxf(S[kt][0], S[kt][1]), fmaxf(S[kt][2], S[kt][3])));
        mx = fmaxf(mx, __shfl_xor(mx, 16)); mx = fmaxf(mx, __shfl_xor(mx, 32));
        const float mn = fmaxf(m[qt], mx), al = __builtin_amdgcn_exp2f(m[qt] - mn); m[qt] = mn; float ps = 0.f;
#pragma unroll
        for (int kt = 0; kt < 4; ++kt)
#pragma unroll
            for (int i = 0; i < 4; ++i) { const float p = __builtin_amdgcn_exp2f(S[kt][i] - mn); S[kt][i] = p; ps += p; }
        l[qt] = l[qt] * al + ps;
#pragma unroll
        for (int dt = 0; dt < 4; ++dt) O[dt][qt] = O[dt][qt] * al;
#pragma unroll
        for (int ks = 0; ks < 2; ++ks) {
            const v4u pw = {pk2(S[2 * ks][0], S[2 * ks][1]), pk2(S[2 * ks][2], S[2 * ks][3]), pk2(S[2 * ks + 1][0], S[2 * ks + 1][1]), pk2(S[2 * ks + 1][2], S[2 * ks + 1][3])};
            const bf16x8 pf = __builtin_bit_cast(bf16x8, pw);
#pragma unroll
            for (int dt = 0; dt < 4; ++dt) { const v2u lo = *(const LAS v2u*)(VTb + (16 * dt + fr) * vpitch + 32 * ks + 4 * fq), hi = *(const LAS v2u*)(VTb + (16 * dt + fr) * vpitch + 32 * ks + 16 + 4 * fq);
                const v4u w = {lo.x, lo.y, hi.x, hi.y}; const bf16x8 vf = __builtin_bit_cast(bf16x8, w);
                O[dt][qt] = __builtin_amdgcn_mfma_f32_16x16x32_bf16(vf, pf, O[dt][qt], 0, 0, 0); }
        }
        __builtin_amdgcn_sched_barrier(0);
    }
}
__device__ __forceinline__ void attn_unit(const Ctx& C, LAS unsigned char* lds, int au) {
    const int tid = C.tid, lane = C.lane, wid = C.wave, fr = lane & 15, fq = lane >> 4;
    const int b = au >> 7, g = (au >> 6) & 1, j = au & 63;
    LAS bf16* Kl = (LAS bf16*)lds;
    LAS bf16* VTl = (LAS bf16*)(lds + 55296);
    LAS bf16* VTc = (LAS bf16*)(lds + 36864);
    LAS float* RT = (LAS float*)(lds + 105472);
    for (int i = tid; i < 4096; i += 512) RT[i] = C.ROPE[i];
    __syncthreads();
    const int pos0 = (j - 1) * 128;
    for (int task = tid; task < 1536; task += 512) { const int rr = task >> 2, dg = task & 3, d0 = 8 * dg, pos = pos0 + rr;
        v4u o1 = {0u, 0u, 0u, 0u}, o2 = {0u, 0u, 0u, 0u};
        if (pos >= 0 && pos < SEQ) { const bf16* src = C.P + ((size_t)b * SEQ + pos) * NP + COL_KA + g * 64; const v4u x1 = *(const v4u*)(src + d0), x2 = *(const v4u*)(src + 32 + d0);
            const LAS float* rt = (dg < 2) ? RT + ((pos >> 6) * 16 + d0) * 2 : RT + ((pos & 63) * 16 + d0 - 16) * 2;
            const float a[8] = {bflo(x1.x), bfhi(x1.x), bflo(x1.y), bfhi(x1.y), bflo(x1.z), bfhi(x1.z), bflo(x1.w), bfhi(x1.w)};
            const float bb[8] = {bflo(x2.x), bfhi(x2.x), bflo(x2.y), bfhi(x2.y), bflo(x2.z), bfhi(x2.z), bflo(x2.w), bfhi(x2.w)};
            float r1[8], r2[8];
#pragma unroll
            for (int e = 0; e < 8; ++e) { const float cs = rt[2 * e], sn = rt[2 * e + 1]; r1[e] = a[e] * cs - bb[e] * sn; r2[e] = bb[e] * cs + a[e] * sn; }
            o1.x = pk2(r1[0], r1[1]); o1.y = pk2(r1[2], r1[3]); o1.z = pk2(r1[4], r1[5]); o1.w = pk2(r1[6], r1[7]);
            o2.x = pk2(r2[0], r2[1]); o2.y = pk2(r2[2], r2[3]); o2.z = pk2(r2[4], r2[5]); o2.w = pk2(r2[6], r2[7]); }
        *(LAS v4u*)(Kl + rr * 72 + d0) = o1; *(LAS v4u*)(Kl + rr * 72 + 32 + d0) = o2; }
    for (int task = tid; task < 3072; task += 512) { const int rr = task >> 3, dg = task & 7, pos = pos0 + rr; v4u raw = {0u, 0u, 0u, 0u};
        if (pos >= 0 && pos < SEQ) raw = *(const v4u*)(C.P + ((size_t)b * SEQ + pos) * NP + COL_VA + g * 64 + 8 * dg);
        VTl[(8 * dg + 0) * 392 + rr] = (bf16)(raw.x & 0xffffu); VTl[(8 * dg + 1) * 392 + rr] = (bf16)(raw.x >> 16);
        VTl[(8 * dg + 2) * 392 + rr] = (bf16)(raw.y & 0xffffu); VTl[(8 * dg + 3) * 392 + rr] = (bf16)(raw.y >> 16);
        VTl[(8 * dg + 4) * 392 + rr] = (bf16)(raw.z & 0xffffu); VTl[(8 * dg + 5) * 392 + rr] = (bf16)(raw.z >> 16);
        VTl[(8 * dg + 6) * 392 + rr] = (bf16)(raw.w & 0xffffu); VTl[(8 * dg + 7) * 392 + rr] = (bf16)(raw.w >> 16); }
    const int gi = wid >> 1, th = wid & 1, hq = g * 4 + gi;
    const float QS = 0.125f * LOG2E;
    bf16x8 qf[4][2];
#pragma unroll
    for (int qt = 0; qt < 4; ++qt) { const int iq = 64 * th + 16 * qt + fr, pos = 128 * j + iq; const bf16* src = C.P + ((size_t)b * SEQ + pos) * NP + COL_QA + hq * 64;
        const v4u x1 = *(const v4u*)(src + 8 * fq), x2 = *(const v4u*)(src + 32 + 8 * fq);
        const LAS float* rt = (fq < 2) ? RT + ((pos >> 6) * 16 + 8 * fq) * 2 : RT + ((pos & 63) * 16 + 8 * fq - 16) * 2;
        const float a[8] = {bflo(x1.x), bfhi(x1.x), bflo(x1.y), bfhi(x1.y), bflo(x1.z), bfhi(x1.z), bflo(x1.w), bfhi(x1.w)};
        const float bb[8] = {bflo(x2.x), bfhi(x2.x), bflo(x2.y), bfhi(x2.y), bflo(x2.z), bfhi(x2.z), bflo(x2.w), bfhi(x2.w)};
        float r1[8], r2[8];
#pragma unroll
        for (int e = 0; e < 8; ++e) { const float cs = rt[2 * e], sn = rt[2 * e + 1]; r1[e] = (a[e] * cs - bb[e] * sn) * QS; r2[e] = (bb[e] * cs + a[e] * sn) * QS; }
        const v4u w1 = {pk2(r1[0], r1[1]), pk2(r1[2], r1[3]), pk2(r1[4], r1[5]), pk2(r1[6], r1[7])}, w2 = {pk2(r2[0], r2[1]), pk2(r2[2], r2[3]), pk2(r2[4], r2[5]), pk2(r2[6], r2[7])};
        qf[qt][0] = __builtin_bit_cast(bf16x8, w1); qf[qt][1] = __builtin_bit_cast(bf16x8, w2); }
    f32x4 O[4][4]; float m[4], l[4];
    const float sinkv = C.sink[hq] * LOG2E;
#pragma unroll
    for (int qt = 0; qt < 4; ++qt) { m[qt] = sinkv; l[qt] = (fq == 0) ? 1.0f : 0.0f;
#pragma unroll
        for (int dt = 0; dt < 4; ++dt) O[dt][qt] = (f32x4){0.f, 0.f, 0.f, 0.f}; }
    __syncthreads();
#pragma unroll 1
    for (int ck = 0; ck < 6; ++ck) {
        if (ck < th || ck > th + 4) continue;
        const int kp0 = pos0 + 64 * ck; if (kp0 + 63 < 0 || kp0 >= SEQ) continue;
        attn_chunk<true>(Kl + 64 * ck * 72, VTl + 64 * ck, 392, qf, O, m, l, fr, fq, 64 * ck, 64 * th + fr, pos0);
    }
    __syncthreads();
    for (int task = tid; task < 2048; task += 512) { const int rr = task >> 3, dg = task & 7; const bf16* src = C.P + ((size_t)ML + (size_t)b * CTXL + rr) * NP;
        const v4u kr = *(const v4u*)(src + COL_KA + g * 64 + 8 * dg), raw = *(const v4u*)(src + COL_VA + g * 64 + 8 * dg);
        *(LAS v4u*)(Kl + rr * 72 + 8 * dg) = kr;
        VTc[(8 * dg + 0) * 264 + rr] = (bf16)(raw.x & 0xffffu); VTc[(8 * dg + 1) * 264 + rr] = (bf16)(raw.x >> 16);
        VTc[(8 * dg + 2) * 264 + rr] = (bf16)(raw.y & 0xffffu); VTc[(8 * dg + 3) * 264 + rr] = (bf16)(raw.y >> 16);
        VTc[(8 * dg + 4) * 264 + rr] = (bf16)(raw.z & 0xffffu); VTc[(8 * dg + 5) * 264 + rr] = (bf16)(raw.z >> 16);
        VTc[(8 * dg + 6) * 264 + rr] = (bf16)(raw.w & 0xffffu); VTc[(8 * dg + 7) * 264 + rr] = (bf16)(raw.w >> 16); }
    __syncthreads();
#pragma unroll 1
    for (int ck = 0; ck < 4; ++ck) attn_chunk<false>(Kl + 64 * ck * 72, VTc + 64 * ck, 264, qf, O, m, l, fr, fq, 0, 0, 0);
#pragma unroll
    for (int qt = 0; qt < 4; ++qt) { float lt = l[qt]; lt += __shfl_xor(lt, 16); lt += __shfl_xor(lt, 32); const float inv = 1.0f / lt;
        const int iq = 64 * th + 16 * qt + fr; bf16* dst = C.H + ((size_t)b * SEQ + 128 * j + iq) * 1024 + 512 + hq * 64 + 4 * fq;
#pragma unroll
        for (int dt = 0; dt < 4; ++dt) { const f32x4 o = O[dt][qt] * inv; v2u w; w.x = pk2(o[0], o[1]); w.y = pk2(o[2], o[3]); *(v2u*)(dst + 16 * dt) = w; } }
    __syncthreads();
}

struct Args { const float* in[17]; float* out; unsigned char* ws; int ph_lo, ph_hi; };
constexpr int N_PHASES = 14;
__global__ void __launch_bounds__(NWAVES * 64, 2) fwd_kernel(Args args) {
    extern __shared__ __attribute__((aligned(16))) unsigned char lds_raw[];
    LAS unsigned char* lds = (LAS unsigned char*)lds_raw;
    cg::grid_group grid = cg::this_grid();
    Ctx C;
    C.x = args.in[0]; C.c = args.in[1]; C.ctx = args.in[2]; C.c_ctx = args.in[3]; C.w_ada = args.in[4]; C.b_ada = args.in[5]; C.ln_g = args.in[6]; C.ln_b = args.in[7];
    C.w13 = args.in[8]; C.w2 = args.in[9]; C.w_in = args.in[10]; C.b_gates = args.in[11]; C.conv_w = args.in[12]; C.conv_b = args.in[13]; C.mh_g = args.in[14]; C.sink = args.in[15]; C.w_out = args.in[16];
    C.out = args.out; C.ws = args.ws;
    unsigned char* ws = args.ws;
    C.MOD = (float*)(ws + WS_MOD); C.ROPE = (float*)(ws + WS_ROPE); C.XC = (float*)(ws + WS_XC); C.GATES = (float*)(ws + WS_GATES); C.NU = (float*)(ws + WS_NU); C.SC = (float*)(ws + WS_SC); C.MS = (float*)(ws + WS_MS);
    C.W13A = (bf16*)(ws + WS_W13A); C.W13B = (bf16*)(ws + WS_W13B); C.W2A = (bf16*)(ws + WS_W2A); C.W2B = (bf16*)(ws + WS_W2B); C.WIN = (bf16*)(ws + WS_WIN); C.WOUT = (bf16*)(ws + WS_WOUT);
    C.H = (bf16*)(ws + WS_H); C.P = (bf16*)(ws + WS_P); C.US = (bf16*)(ws + WS_US);
    C.tid = threadIdx.x; C.lane = C.tid & 63; C.wave = __builtin_amdgcn_readfirstlane(C.tid >> 6); C.G = gridDim.x; C.bx = blockIdx.x;
    const int lo = args.ph_lo, hi = args.ph_hi;
#ifndef PH_ENABLE
#define PH_ENABLE 0xFFFF
#endif
#define IN(k) ((((PH_ENABLE) >> (k)) & 1) && lo <= (k) && (k) < hi)
#define SEAM(k) do { if (IN(k) && IN((k) + 1)) grid.sync(); } while (0)
    typedef pg8::StaticOrder SO;
    if (IN(0)) { p0_prologue(C, lds); } SEAM(0);
    if (IN(1)) { p1_modulate(C); } SEAM(1);
    if (IN(2)) { pg8::Gemm g{C.H, C.W13A, MT, 2 * DFF, DM}; SO S; S.init(MT, 2 * DFF, C.G, C.bx); pg8::EpiSwiglu E{C.P, DFF};
        pg8::gemm_phase<pg8::EpiSwiglu, SO, true, true>(lds, g, S, E); } SEAM(2);
    if (IN(3)) { pg8::Gemm g{C.P, C.W2A, MT, DM, DFF}; SO S; S.init(MT, DM, C.G, C.bx); pg8::EpiRes E{C.x, C.ctx, C.out, C.XC, C.MOD, 2, 0.5f, ALPHA_RES};
        pg8::gemm_phase<pg8::EpiRes, SO, true, true>(lds, g, S, E); } SEAM(3);
    if (IN(4)) { ln_phase<true, true>(C, lds, C.out, C.XC, C.out, C.XC, MT, 0, 3, 4); } SEAM(4);
    if (IN(5)) { pg8::Gemm g{C.H, C.WIN, MT, NP, DM}; SO S; S.init(MT, NP, C.G, C.bx); pg8::EpiBf16<0> E{C.P, NP, nullptr, 0, 0, 1.f};
        pg8::gemm_phase<pg8::EpiBf16<0>, SO, true, true>(lds, g, S, E); } SEAM(5);
    if (IN(6)) { for (int u = C.bx; u < NUNIT; u += C.G) mlstm_local_unit(C, lds, u);
        for (int au = C.bx; au < 256; au += C.G) attn_unit(C, lds, au); } SEAM(6);
    if (IN(7)) { p7_scan(C); } SEAM(7);
    if (IN(8)) { for (int u = C.bx; u < NUNIT_L; u += C.G) mlstm_out_unit(C, lds, u); } SEAM(8);
    if (IN(9)) { pg8::Gemm g{C.H, C.WOUT, ML, DM, DM}; SO S; S.init(ML, DM, C.G, C.bx); pg8::EpiRes E{C.out, C.XC, C.out, C.XC, C.MOD, 5, 1.0f, ALPHA_RES};
        pg8::gemm_phase<pg8::EpiRes, SO, true, true>(lds, g, S, E); } SEAM(9);
    if (IN(10)) { ln_phase<true, false>(C, lds, C.out, C.XC, C.out, C.XC, ML, 1, 6, 7); } SEAM(10);
    if (IN(11)) { pg8::Gemm g{C.H, C.W13B, ML, 2 * DFF, DM}; SO S; S.init(ML, 2 * DFF, C.G, C.bx); pg8::EpiSwiglu E{C.P, DFF};
        pg8::gemm_phase<pg8::EpiSwiglu, SO, true, true>(lds, g, S, E); } SEAM(11);
    if (IN(12)) { pg8::Gemm g{C.P, C.W2B, ML, DM, DFF}; SO S; S.init(ML, DM, C.G, C.bx); pg8::EpiRes E{C.out, C.XC, C.out, C.XC, C.MOD, 8, 0.5f, ALPHA_RES};
        pg8::gemm_phase<pg8::EpiRes, SO, true, true>(lds, g, S, E); } SEAM(12);
    if (IN(13)) { ln_phase<false, false>(C, lds, C.out, C.XC, C.out, C.XC, ML, 2, 0, 0); }
#undef IN
#undef SEAM
}

#ifndef MK_MULTI
#define MK_MULTI 0
#endif
extern "C" void kernel_launch(void* const* d_in, const int* in_sizes, int n_in, void* d_out, int out_size, void* d_ws, size_t ws_size, hipStream_t stream) {
    static int grid = 0;
    if (grid == 0) {
        if (n_in != 17 || out_size != ML * DM || ws_size < WS_END) { fprintf(stderr, "kernel_launch: unexpected problem (n_in %d out %d ws %zu)\n", n_in, out_size, ws_size); grid = -1; return; }
        int dev = 0, cus = 0, per_cu = 0;
        (void)hipGetDevice(&dev); (void)hipDeviceGetAttribute(&cus, hipDeviceAttributeMultiprocessorCount, dev);
        if (hipFuncSetAttribute((const void*)fwd_kernel, hipFuncAttributeMaxDynamicSharedMemorySize, LDS_BYTES) != hipSuccess) { fprintf(stderr, "kernel_launch: hipFuncSetAttribute failed\n"); grid = -1; return; }
        if (hipOccupancyMaxActiveBlocksPerMultiprocessor(&per_cu, (const void*)fwd_kernel, NWAVES * 64, LDS_BYTES) != hipSuccess || per_cu < 1) { per_cu = 1; (void)hipGetLastError(); }
        grid = cus * 1;
        if (grid > 256) grid = 256;
        fprintf(stderr, "kernel_launch: grid %d (cus %d, per_cu %d)\n", grid, cus, per_cu);
    }
    if (grid < 0) return;
    Args a{};
    for (int i = 0; i < 17; ++i) a.in[i] = (const float*)d_in[i];
    a.out = (float*)d_out; a.ws = (unsigned char*)d_ws;
#if MK_MULTI
    for (int p = 0; p < N_PHASES; ++p) { a.ph_lo = p; a.ph_hi = p + 1; hipLaunchKernelGGL(fwd_kernel, dim3(grid), dim3(NWAVES * 64), LDS_BYTES, stream, a); }
#else
    a.ph_lo = 0; a.ph_hi = N_PHASES;
    void* kargs[] = {&a};
    hipError_t e = hipLaunchCooperativeKernel((const void*)fwd_kernel, dim3(grid), dim3(NWAVES * 64), kargs, LDS_BYTES, stream);
    if (e != hipSuccess) fprintf(stderr, "kernel_launch: cooperative launch failed: %s (grid %d)\n", hipGetErrorString(e), grid);
#endif
}
```

```cpp
#include <hip/hip_runtime.h>
#include <hip/hip_cooperative_groups.h>
#include <cstdio>
#include <cstdint>
#include <cmath>
namespace cg = cooperative_groups;
namespace pg8 {
#define PG8_LAS __attribute__((address_space(3)))
typedef unsigned short bf16_t;
typedef short bf16x8 __attribute__((ext_vector_type(8)));
typedef float f32x4 __attribute__((ext_vector_type(4)));
typedef unsigned u32x4 __attribute__((ext_vector_type(4)));
constexpr int BM = 256, BK = 64, HALF = 128, HTB = HALF * BK * 2  , STAGE_BYTES = 8 * HTB, NXCD = 8, WGM = 8;

__host__ __device__ __forceinline__ int lds_byte(int r, int c) { const int st = (r >> 4) * 2 + (c >> 5), rr = r & 15, cc = c & 31, ob = rr * 64 + cc * 2; return st * 1024 + (ob ^ (((ob >> 9) & 1) << 5)); }
__host__ __device__ __forceinline__ void stage_rc(int b, int& R, int& C) { const int st = b / 1024, sb = b % 1024, swz = sb ^ (((sb >> 9) & 1) << 5); R = (st >> 1) * 16 + swz / 64; C = (st & 1) * 32 + (swz % 64) / 2; }
__host__ __device__ __forceinline__ int perm32(int rho) { const int n = rho >> 4, i = rho & 15; return 8 * (i >> 2) + 4 * n + (i & 3); }

struct Unit { int pm, pn; };
struct Gemm { const bf16_t* A; const bf16_t* Bt; int M, N, K; };

struct StaticOrder {
    int nM, nN, nwg, G, c;
    __host__ __device__ void init(int M, int N, int G_, int c_) { nM = M / BM; nN = N / BM; nwg = nM * nN; G = G_; c = c_; }
    __host__ __device__ bool next(int i, Unit& u) const {
        const long L = (long)i * G + c; if (L >= nwg) return false;
        int wgid = (int)L; { const int q = nwg / NXCD, r = nwg % NXCD, xcd = wgid % NXCD, off = wgid / NXCD; wgid = (xcd < r ? xcd * (q + 1) : r * (q + 1) + (xcd - r) * q) + off; }
        const int nig = WGM * nN, gid = wgid / nig, fm = gid * WGM, gsz = (nM - fm) < WGM ? (nM - fm) : WGM;
        u.pm = fm + ((wgid % nig) % gsz); u.pn = (wgid % nig) / gsz; return true;
    }
    __device__ __forceinline__ void a_ready(const Unit&) const {}
    __device__ __forceinline__ void done(const Unit&) const {}
};

__device__ __forceinline__ unsigned cvt_pk_bf16(float lo, float hi) { unsigned r; asm volatile("v_cvt_pk_bf16_f32 %0, %1, %2" : "=v"(r) : "v"(lo), "v"(hi)); return r; }
typedef float f32x2 __attribute__((ext_vector_type(2)));
__device__ __forceinline__ f32x2 gelu_pk(f32x2 v) {
    const f32x2 av = __builtin_elementwise_abs(v), d = av * 0.2316418882f + 1.0f;
    f32x2 t; t.x = __builtin_amdgcn_rcpf(d.x); t.y = __builtin_amdgcn_rcpf(d.y);
    f32x2 q = t * 0.5307027145f + (-0.7265760135f); q = q * t + 0.7107068705f; q = q * t + (-0.142248368f); q = q * t + 0.127414796f; q = q * t;
    const f32x2 s = (v * v) * (-0.72134752044f);
    f32x2 e; e.x = __builtin_amdgcn_exp2f(s.x); e.y = __builtin_amdgcn_exp2f(s.y);
    const f32x2 m = v * (q * e), r = v - m;
    f32x2 o; o.x = v.x < 0.f ? m.x : r.x; o.y = v.y < 0.f ? m.y : r.y; return o;
}

template <int ACT  > struct EpiBf16 {
    static constexpr bool PERM = true, AFTER_DRAIN = false; static_assert(ACT == 0 || ACT == 1, "EpiBf16: ACT is 0 (none) or 1 (gelu_pk)");
    bf16_t* O; int ldc; const float* bias; int split_cols; size_t split_stride; float scale0;
    __device__ __forceinline__ void operator()(const f32x4 (&acc)[2][2][4][2], const Unit& u, int wr, int wc, int fr, int fq) const {
        const int row0 = u.pm * BM + wr * 64 + fr; int colt = u.pn * BM; bf16_t* base = O;
        float sc = 1.f; if (split_cols) { const int t = colt / split_cols; base += (size_t)t * split_stride; colt -= t * split_cols; if (t == 0) sc = scale0; }
        const int col0 = colt + wc * 32 + 8 * fq, bcol0 = u.pn * BM + wc * 32 + 8 * fq;
        f32x4 bv[2][2];
#pragma unroll
        for (int bj = 0; bj < 2; ++bj)
#pragma unroll
            for (int n = 0; n < 2; ++n) bv[bj][n] = bias ? *(const f32x4*)(bias + bcol0 + bj * HALF + 4 * n) : (f32x4){0.f, 0.f, 0.f, 0.f};
#pragma unroll
        for (int ai = 0; ai < 2; ++ai)
#pragma unroll
            for (int m = 0; m < 4; ++m) { bf16_t* rowp = base + (size_t)(row0 + ai * HALF + m * 16) * ldc + col0;
#pragma unroll
                for (int bj = 0; bj < 2; ++bj) { f32x4 v0 = acc[ai][bj][m][0] + bv[bj][0], v1 = acc[ai][bj][m][1] + bv[bj][1];
                    if (ACT == 1) { f32x2 a = gelu_pk((f32x2){v0[0], v0[1]}), b = gelu_pk((f32x2){v0[2], v0[3]}), c = gelu_pk((f32x2){v1[0], v1[1]}), d = gelu_pk((f32x2){v1[2], v1[3]});
                        v0 = (f32x4){a.x, a.y, b.x, b.y}; v1 = (f32x4){c.x, c.y, d.x, d.y}; }
                    v0 = v0 * sc; v1 = v1 * sc; u32x4 w; w.x = cvt_pk_bf16(v0[0], v0[1]); w.y = cvt_pk_bf16(v0[2], v0[3]); w.z = cvt_pk_bf16(v1[0], v1[1]); w.w = cvt_pk_bf16(v1[2], v1[3]);
                    *(u32x4*)(rowp + bj * HALF) = w; } }
    }
};
__device__ __forceinline__ float silu_f(float x) { return x * __builtin_amdgcn_rcpf(1.0f + __builtin_amdgcn_exp2f(-1.4426950408889634f * x)); }
struct EpiSwiglu {
    static constexpr bool PERM = true, AFTER_DRAIN = false;
    bf16_t* O; int ldc;
    __device__ __forceinline__ void operator()(const f32x4 (&acc)[2][2][4][2], const Unit& u, int wr, int wc, int fr, int fq) const {
        const int row0 = u.pm * BM + wr * 64 + fr; const int col0 = u.pn * HALF + wc * 32 + 8 * fq;
#pragma unroll
        for (int ai = 0; ai < 2; ++ai)
#pragma unroll
            for (int m = 0; m < 4; ++m) {
                bf16_t* rowp = O + (size_t)(row0 + ai * HALF + m * 16) * ldc + col0;
                const f32x4 g0 = acc[ai][0][m][0], g1 = acc[ai][0][m][1], u0 = acc[ai][1][m][0], u1 = acc[ai][1][m][1];
                u32x4 w;
                w.x = cvt_pk_bf16(silu_f(g0[0]) * u0[0], silu_f(g0[1]) * u0[1]); w.y = cvt_pk_bf16(silu_f(g0[2]) * u0[2], silu_f(g0[3]) * u0[3]);
                w.z = cvt_pk_bf16(silu_f(g1[0]) * u1[0], silu_f(g1[1]) * u1[1]); w.w = cvt_pk_bf16(silu_f(g1[2]) * u1[2], silu_f(g1[3]) * u1[3]);
                *(u32x4*)rowp = w;
            }
    }
};
struct EpiRes {
    static constexpr bool PERM = false, AFTER_DRAIN = false;
    const float* src_lat; const float* src_ctx; float* dst_lat; float* dst_ctx; const float* mod; int gi; float coef; float alpha;
    __device__ __forceinline__ void operator()(const f32x4 (&acc)[2][2][4][2], const Unit& u, int wr, int wc, int fr, int fq) const {
        const int pm = u.pm; const bool isctx = pm >= 64;
        const float* sb = isctx ? src_ctx + (size_t)(pm - 64) * BM * 1024 : src_lat + (size_t)pm * BM * 1024;
        float* db = isctx ? dst_ctx + (size_t)(pm - 64) * BM * 1024 : dst_lat + (size_t)pm * BM * 1024;
        const int vb = isctx ? 2 : (pm >= 32 ? 1 : 0);
        const float* gv = mod + vb * 9216 + gi * 1024;
        const int rl0 = wr * 64 + fr, col0 = u.pn * BM + wc * 32 + 4 * fq;
#pragma unroll
        for (int bj = 0; bj < 2; ++bj)
#pragma unroll
            for (int n = 0; n < 2; ++n) {
                const int c = col0 + bj * HALF + n * 16;
                const f32x4 g = *(const f32x4*)(gv + c) * coef;
#pragma unroll
                for (int ai = 0; ai < 2; ++ai)
#pragma unroll
                    for (int m = 0; m < 4; ++m) {
                        const size_t off = (size_t)(rl0 + ai * HALF + m * 16) * 1024 + c;
                        const f32x4 xv = *(const f32x4*)(sb + off);
                        *(f32x4*)(db + off) = xv * alpha + g * acc[ai][bj][m][n];
                    }
            }
    }
};
template <class Epi, class Sched, bool ALIGN_EPI = false, bool SP2 = false>
__device__ __forceinline__ void gemm_phase(PG8_LAS unsigned char* lds, const Gemm g, const Sched& S, const Epi& E) {
    const int tid = threadIdx.x, wid = __builtin_amdgcn_readfirstlane(tid >> 6), lane = tid & 63, wr = wid >> 2, wc = wid & 3, fr = lane & 15, fq = lane >> 4;
    const int K = g.K, nt = K / BK;
    unsigned voffA[2], voffB[2];
#pragma unroll
    for (int i = 0; i < 2; ++i) { int R, C; stage_rc(tid * 16 + i * 8192, R, C); const int Rb = Epi::PERM ? ((R & ~31) + perm32(R & 31)) : R;
        voffA[i] = (unsigned)(R * K + C) * 2u; voffB[i] = (unsigned)(Rb * K + C) * 2u; }
    const size_t kstep = (size_t)(BK * 2);
    const size_t hstep = (size_t)HALF * K * 2;
    const size_t tstep = 2 * hstep;
    const unsigned ldsw = (unsigned)wid * 1024u;
    const int aoff = lds_byte(wr * 64 + fr, fq * 8), boff = lds_byte(wc * 32 + fr, fq * 8);
#define PG8_SA(b, h) (((b) * 2 + (h)) * HTB)
#define PG8_SB(b, h) ((4 + (b) * 2 + (h)) * HTB)
#define PG8_STAGE(bufoff, gbase, voff) do { _Pragma("unroll") for (int _i = 0; _i < 2; ++_i) \
        __builtin_amdgcn_global_load_lds((const unsigned*)((const char*)(gbase) + (voff)[_i]), (PG8_LAS unsigned*)(lds + (bufoff) + ldsw + _i * 8192), 16, 0, 0); } while (0)
#define PG8_LDA(dst, b, h) do { _Pragma("unroll") for (int m = 0; m < 4; ++m) _Pragma("unroll") for (int k = 0; k < 2; ++k) dst[m][k] = *(const PG8_LAS bf16x8*)(lds + PG8_SA(b, h) + aoff + m * 2048 + k * 1024); } while (0)
#define PG8_LDB(dst, b, h) do { _Pragma("unroll") for (int n = 0; n < 2; ++n) _Pragma("unroll") for (int k = 0; k < 2; ++k) dst[n][k] = *(const PG8_LAS bf16x8*)(lds + PG8_SB(b, h) + boff + n * 2048 + k * 1024); } while (0)
#define PG8_MMA(ai, bj, At, Bt) do { __builtin_amdgcn_s_setprio(1); _Pragma("unroll") for (int m = 0; m < 4; ++m) _Pragma("unroll") for (int n = 0; n < 2; ++n) _Pragma("unroll") for (int k = 0; k < 2; ++k) \
        acc[ai][bj][m][n] = __builtin_amdgcn_mfma_f32_16x16x32_bf16(Bt[n][k], At[m][k], acc[ai][bj][m][n], 0, 0, 0); __builtin_amdgcn_s_setprio(0); } while (0)
#define PG8_WAIT_V(n) asm volatile("s_waitcnt vmcnt(" #n ")" ::: "memory")
#define PG8_WAIT_L(n) asm volatile("s_waitcnt lgkmcnt(" #n ")" ::: "memory")
#define PG8_BAR __builtin_amdgcn_s_barrier()
#define PG8_SCHED __builtin_amdgcn_sched_barrier(0)
    Unit cur, nxt; int ui = 0;
    if (!S.next(0, cur)) return;
    f32x4 acc[2][2][4][2];
#pragma unroll
    for (int a = 0; a < 2; ++a)
#pragma unroll
        for (int b = 0; b < 2; ++b)
#pragma unroll
            for (int m = 0; m < 4; ++m)
#pragma unroll
                for (int n = 0; n < 2; ++n) acc[a][b][m][n] = (f32x4){0.f, 0.f, 0.f, 0.f};
    bf16x8 At[4][2], B0[2][2], B1[2][2];
    const char* cA = (const char*)g.A + (size_t)cur.pm * tstep; const char* cB = (const char*)g.Bt + (size_t)cur.pn * tstep;
    S.a_ready(cur);
    if constexpr (SP2) {
        PG8_STAGE(PG8_SB(0, 0), cB, voffB); PG8_STAGE(PG8_SB(0, 1), cB + hstep, voffB); PG8_STAGE(PG8_SA(0, 0), cA, voffA); PG8_STAGE(PG8_SA(0, 1), cA + hstep, voffA);
        if (wr == 1) PG8_BAR;
        PG8_WAIT_V(2); PG8_BAR;
        PG8_STAGE(PG8_SB(1, 0), cB + kstep, voffB); PG8_STAGE(PG8_SA(1, 0), cA + kstep, voffA); PG8_STAGE(PG8_SB(1, 1), cB + hstep + kstep, voffB);
        PG8_WAIT_V(6); PG8_BAR;
    } else {
        PG8_STAGE(PG8_SB(0, 0), cB, voffB); PG8_STAGE(PG8_SA(0, 0), cA, voffA); PG8_STAGE(PG8_SB(0, 1), cB + hstep, voffB); PG8_STAGE(PG8_SA(0, 1), cA + hstep, voffA);
        if (wr == 1) PG8_BAR;
        PG8_WAIT_V(4); PG8_BAR;
        PG8_STAGE(PG8_SB(1, 0), cB + kstep, voffB); PG8_STAGE(PG8_SA(1, 0), cA + kstep, voffA); PG8_STAGE(PG8_SB(1, 1), cB + hstep + kstep, voffB);
        PG8_WAIT_V(6); PG8_BAR;
    }
    for (;;) {
        const bool has_next = S.next(ui + 1, nxt);
        const char* nA = has_next ? (const char*)g.A + (size_t)nxt.pm * tstep : cA; const char* nB = has_next ? (const char*)g.Bt + (size_t)nxt.pn * tstep : cB;
        for (int t = 0; t < nt; t += 2) {
            const bool last = (t == nt - 2);
            const char* a1 = cA + (size_t)(t + 1) * kstep;
            const char* a2 = last ? nA : cA + (size_t)(t + 2) * kstep; const char* b2 = last ? nB : cB + (size_t)(t + 2) * kstep;
            const char* a3 = a2 + kstep; const char* b3 = b2 + kstep;
            if (last && has_next) S.a_ready(nxt);
            if constexpr (SP2) {
            PG8_LDB(B0, 0, 0); PG8_LDB(B1, 0, 1); PG8_SCHED; PG8_LDA(At, 0, 0); PG8_STAGE(PG8_SA(1, 1), a1 + hstep, voffA);
            PG8_WAIT_V(8); PG8_WAIT_L(0); PG8_BAR; PG8_MMA(0, 0, At, B0); PG8_MMA(0, 1, At, B1); PG8_BAR; PG8_SCHED;
            PG8_LDA(At, 0, 1); PG8_STAGE(PG8_SB(0, 0), b2, voffB); PG8_STAGE(PG8_SB(0, 1), b2 + hstep, voffB); PG8_STAGE(PG8_SA(0, 0), a2, voffA);
            PG8_WAIT_V(8); PG8_WAIT_L(0); PG8_BAR; PG8_MMA(1, 0, At, B0); PG8_MMA(1, 1, At, B1); PG8_BAR; PG8_SCHED;
            PG8_LDB(B0, 1, 0); PG8_LDB(B1, 1, 1); PG8_SCHED; PG8_LDA(At, 1, 0); PG8_STAGE(PG8_SA(0, 1), a2 + hstep, voffA);
            PG8_WAIT_V(8); PG8_WAIT_L(0); PG8_BAR; PG8_MMA(0, 0, At, B0); PG8_MMA(0, 1, At, B1); PG8_BAR; PG8_SCHED;
            PG8_LDA(At, 1, 1); PG8_STAGE(PG8_SB(1, 0), b3, voffB); PG8_STAGE(PG8_SB(1, 1), b3 + hstep, voffB); PG8_STAGE(PG8_SA(1, 0), a3, voffA);
            PG8_WAIT_V(8); PG8_WAIT_L(0); PG8_BAR; PG8_MMA(1, 0, At, B0); PG8_MMA(1, 1, At, B1); PG8_BAR; PG8_SCHED;
            } else {
            PG8_LDB(B0, 0, 0); PG8_SCHED; PG8_LDA(At, 0, 0); PG8_STAGE(PG8_SA(1, 1), a1 + hstep, voffA);
            PG8_WAIT_L(8); PG8_BAR; PG8_WAIT_L(0); PG8_MMA(0, 0, At, B0); PG8_BAR; PG8_SCHED;
            PG8_LDB(B1, 0, 1); PG8_STAGE(PG8_SB(0, 0), b2, voffB);
            PG8_BAR; PG8_WAIT_L(0); PG8_MMA(0, 1, At, B1); PG8_BAR;
            PG8_LDA(At, 0, 1); PG8_STAGE(PG8_SA(0, 0), a2, voffA);
            PG8_BAR; PG8_WAIT_L(0); PG8_MMA(1, 0, At, B0); PG8_BAR; PG8_SCHED;
            PG8_STAGE(PG8_SB(0, 1), b2 + hstep, voffB);
            PG8_WAIT_V(6); PG8_BAR; PG8_MMA(1, 1, At, B1); PG8_BAR;
            PG8_LDB(B0, 1, 0); PG8_SCHED; PG8_LDA(At, 1, 0); PG8_STAGE(PG8_SA(0, 1), a2 + hstep, voffA);
            PG8_WAIT_L(8); PG8_BAR; PG8_WAIT_L(0); PG8_MMA(0, 0, At, B0); PG8_BAR; PG8_SCHED;
            PG8_LDB(B1, 1, 1); PG8_STAGE(PG8_SB(1, 0), b3, voffB);
            PG8_BAR; PG8_WAIT_L(0); PG8_MMA(0, 1, At, B1); PG8_BAR;
            PG8_LDA(At, 1, 1); PG8_STAGE(PG8_SA(1, 0), a3, voffA);
            PG8_BAR; PG8_WAIT_L(0); PG8_MMA(1, 0, At, B0); PG8_BAR; PG8_SCHED;
            PG8_STAGE(PG8_SB(1, 1), b3 + hstep, voffB);
            PG8_WAIT_V(6); PG8_BAR; PG8_MMA(1, 1, At, B1); PG8_BAR;
            }
        }
        if constexpr (ALIGN_EPI) { if (wr == 0) PG8_BAR; }
        if constexpr (!Epi::AFTER_DRAIN) { E(acc, cur, wr, wc, fr, fq); S.done(cur); }
        if (!has_next) break;
#pragma unroll
        for (int a = 0; a < 2; ++a)
#pragma unroll
            for (int b = 0; b < 2; ++b)
#pragma unroll
                for (int m = 0; m < 4; ++m)
#pragma unroll
                    for (int n = 0; n < 2; ++n) acc[a][b][m][n] = (f32x4){0.f, 0.f, 0.f, 0.f};
        cur = nxt; cA = nA; cB = nB; ++ui;
        if constexpr (ALIGN_EPI) { if (wr == 1) PG8_BAR; }
    }
    PG8_WAIT_V(0);
    if constexpr (!ALIGN_EPI) { if (wr == 0) PG8_BAR; }
    PG8_BAR;
    if constexpr (Epi::AFTER_DRAIN) { E.fused(acc, cur, wr, wc, fr, fq, lds, wid, lane); S.done(cur); }
#undef PG8_SA
#undef PG8_SB
#undef PG8_STAGE
#undef PG8_LDA
#undef PG8_LDB
#undef PG8_MMA
#undef PG8_WAIT_V
#undef PG8_WAIT_L
#undef PG8_BAR
#undef PG8_SCHED
}
}
#define LAS __attribute__((address_space(3)))
typedef unsigned short bf16;
typedef unsigned v4u __attribute__((ext_vector_type(4)));
typedef unsigned v2u __attribute__((ext_vector_type(2)));
typedef float f32x4 __attribute__((ext_vector_type(4)));
typedef short bf16x8 __attribute__((ext_vector_type(8)));
typedef short bf16x4 __attribute__((ext_vector_type(4)));
#define LDS_WAIT() asm volatile("s_waitcnt lgkmcnt(0)" ::: "memory")

constexpr int NWAVES = 8;
constexpr int ML = 16384, MC = 512, MT = ML + MC, DM = 1024, DFF = 2816, NP = 2816, SEQ = 8192, CTXL = 256;
constexpr int COL_QM = 0, COL_KM = 512, COL_VM = 1024, COL_OM = 1536, COL_QA = 2048, COL_KA = 2560, COL_VA = 2688;
constexpr float LN_EPS = 1e-5f;
constexpr float ALPHA_RES = 1.189207115002721f;
constexpr float LOG2E = 1.4426950408889634f;
constexpr size_t MiB = 1u << 20;
constexpr size_t WS_BAR = 0, WS_BAR_BYTES = 16384;
constexpr size_t WS_MOD = 1 * MiB, WS_ROPE = 1 * MiB + 256 * 1024;
constexpr size_t WS_W13A = 2 * MiB, WS_W13B = 13 * MiB, WS_W2A = 24 * MiB, WS_W2B = 30 * MiB, WS_WIN = 36 * MiB, WS_WOUT = 42 * MiB;
constexpr size_t WS_XC = 44 * MiB, WS_GATES = 46 * MiB, WS_NU = 48 * MiB, WS_SC = 49 * MiB + 512 * 1024, WS_MS = 49 * MiB + 768 * 1024;
constexpr size_t WS_H = 50 * MiB, WS_P = 83 * MiB, WS_US = 174 * MiB, WS_END = 240 * MiB;
constexpr int LDS_BYTES = 147456;
constexpr int NUNIT_L = 1024, NUNIT = 1056;

struct Ctx {
    const float *x, *c, *ctx, *c_ctx, *w_ada, *b_ada, *ln_g, *ln_b, *w13, *w2, *w_in, *b_gates, *conv_w, *conv_b, *mh_g, *sink, *w_out;
    float* out; unsigned char* ws;
    float *MOD, *ROPE, *XC, *GATES, *NU, *SC, *MS;
    bf16 *W13A, *W13B, *W2A, *W2B, *WIN, *WOUT, *H, *P, *US;
    int tid, lane, wave, G, bx;
};

typedef float f32x2_t __attribute__((ext_vector_type(2))); typedef __bf16 bf16x2_t __attribute__((ext_vector_type(2)));
__device__ __forceinline__ unsigned pk2(float lo, float hi) { f32x2_t v = {lo, hi}; bf16x2_t b = __builtin_convertvector(v, bf16x2_t); return __builtin_bit_cast(unsigned, b); }
__device__ __forceinline__ float bflo(unsigned w) { return __uint_as_float(w << 16); }
__device__ __forceinline__ float bfhi(unsigned w) { return __uint_as_float(w & 0xffff0000u); }
__device__ __forceinline__ float bf1(unsigned short h) { return __uint_as_float((unsigned)h << 16); }
__device__ __forceinline__ float wave_sum(float v) {
#pragma unroll
    for (int o = 1; o < 64; o <<= 1) v += __shfl_xor(v, o);
    return v;
}
__device__ __forceinline__ float wave_max(float v) {
#pragma unroll
    for (int o = 1; o < 64; o <<= 1) v = fmaxf(v, __shfl_xor(v, o));
    return v;
}
__device__ __forceinline__ float logsig(float g) { return g >= 0.f ? -log1pf(__expf(-g)) : g - log1pf(__expf(g)); }
__device__ __forceinline__ float sigmoid_f(float x) { return __builtin_amdgcn_rcpf(1.0f + __builtin_amdgcn_exp2f(-LOG2E * x)); }

#define XB_TMO      128
#define XB_XCNT(j)  (256  + 64 * (j))
#define XB_XSUB(j)  (1280 + 64 * (j))
#define XB_XGEN(j)  (2304 + 64 * (j))
#define XB_TOP      3328
#define XB_TOPGEN   3392
#define XCD_BAR_WORDS 3456
#define XB_SPIN_CAP (1u << 18)

__device__ __forceinline__ unsigned xb_ld(unsigned* p)              { return __hip_atomic_load(p, __ATOMIC_RELAXED, __HIP_MEMORY_SCOPE_AGENT); }
__device__ __forceinline__ unsigned xb_add(unsigned* p, unsigned v) { return __hip_atomic_fetch_add(p, v, __ATOMIC_RELAXED, __HIP_MEMORY_SCOPE_AGENT); }
__device__ __forceinline__ unsigned xb_xcc_id() { return (unsigned)__builtin_amdgcn_s_getreg((3 << 11) | 20) & 0xFu; }
#define XB_SPIN(cond, bar) do { unsigned _sp = 0; while (cond) { __builtin_amdgcn_s_sleep(1); \
    if ((++_sp & 255u) == 0u) { if (xb_ld(&(bar)[XB_TMO])) break; if (_sp > XB_SPIN_CAP) { atomicAdd(&(bar)[XB_TMO], 1u); break; } } } } while (0)

struct XcdBarrier {
    unsigned* bar; unsigned x;
    volatile LAS unsigned* st;
};

__device__ __forceinline__ XcdBarrier xcd_barrier_post(unsigned* bar, volatile LAS unsigned* st) {
    XcdBarrier b; b.bar = bar; b.x = xb_xcc_id(); b.st = st;
    if (threadIdx.x == 0) (void)xb_add(&bar[XB_XCNT(b.x)], 1u);
    return b;
}
__device__ __forceinline__ void xcd_barrier_complete(unsigned* bar, unsigned x, unsigned& nloc, unsigned& nx) {
    const unsigned G = gridDim.x * gridDim.y * gridDim.z;
    unsigned sum, cnt, mine, sp = 0u;
    for (;;) {
        sum = 0u; cnt = 0u; mine = 0u;
#pragma unroll
        for (unsigned j = 0; j < 16; ++j) { const unsigned c = xb_ld(&bar[XB_XCNT(j)]); sum += c; cnt += (c > 0u) ? 1u : 0u; mine = (j == x) ? c : mine; }
        if (sum == G) break;
        __builtin_amdgcn_s_sleep(1);
        if ((++sp & 255u) == 0u) { if (xb_ld(&bar[XB_TMO])) break; if (sp > XB_SPIN_CAP) { atomicAdd(&bar[XB_TMO], 1u); break; } }
    }
    nloc = mine > 0u ? mine : 1u; nx = cnt > 0u ? cnt : 1u;
}

__device__ __forceinline__ void xcd_barrier(const XcdBarrier& b) {
    asm volatile("s_waitcnt vmcnt(0)" ::: "memory");
    __syncthreads();
    if (threadIdx.x == 0) {
        unsigned* bar = b.bar;
        __builtin_amdgcn_s_waitcnt(0);
        unsigned nloc = b.st[0], nx = b.st[1];
        if (nloc == 0u) { xcd_barrier_complete(bar, b.x, nloc, nx); b.st[0] = nloc; b.st[1] = nx; }
        const unsigned old = xb_add(&bar[XB_XSUB(b.x)], 1u);
        const unsigned gen = old / nloc;
        if (old + 1u == (gen + 1u) * nloc) {
            __builtin_amdgcn_fence(__ATOMIC_RELEASE, "agent");
            asm volatile("s_waitcnt vmcnt(0)" ::: "memory");
            const unsigned og = xb_add(&bar[XB_TOP], 1u);
            const unsigned tg = og / nx;
            if (og + 1u == (tg + 1u) * nx) xb_add(&bar[XB_TOPGEN], 1u);
            else XB_SPIN(xb_ld(&bar[XB_TOPGEN]) == tg, bar);
            __builtin_amdgcn_fence(__ATOMIC_ACQUIRE, "agent");
            xb_add(&bar[XB_XGEN(b.x)], 1u);
            asm volatile("s_waitcnt vmcnt(0)" ::: "memory");
        } else {
            XB_SPIN(xb_ld(&bar[XB_XGEN(b.x)]) == gen, bar);
            __builtin_amdgcn_fence(__ATOMIC_ACQUIRE, "agent");
            asm volatile("s_waitcnt vmcnt(0)" ::: "memory");
        }
    }
    __syncthreads();
}

__device__ __forceinline__ void tr_item(const float* W, int srcN, int srcCol0, int k0, bf16* WT, int K, int dstRow0, LAS float* scr, int lane) {
#pragma unroll 8
    for (int i = 0; i < 32; ++i) { const int kk = 2 * i + (lane >> 5); scr[kk * 33 + (lane & 31)] = W[(size_t)(k0 + kk) * srcN + srcCol0 + (lane & 31)]; }
    LDS_WAIT(); asm volatile("" ::: "memory");
    const int c = lane & 7;
#pragma unroll
    for (int j = 0; j < 4; ++j) { const int n = (lane >> 3) + 8 * j; const LAS float* s = scr + (8 * c) * 33 + n;
        v4u o; o.x = pk2(s[0 * 33], s[1 * 33]); o.y = pk2(s[2 * 33], s[3 * 33]); o.z = pk2(s[4 * 33], s[5 * 33]); o.w = pk2(s[6 * 33], s[7 * 33]);
        *(v4u*)(WT + (size_t)(dstRow0 + n) * K + k0 + 8 * c) = o; }
    LDS_WAIT(); asm volatile("" ::: "memory");
}
__device__ __forceinline__ void p0_prologue(const Ctx& C, LAS unsigned char* lds) {
    const int tid = C.tid;
    {
        LAS float* sc = (LAS float*)lds; LAS float* part = sc + 3072;
        for (int i = tid; i < 3072; i += 512) { const int v = i >> 10, k = i & 1023; const float cv = v < 2 ? C.c[v * 1024 + k] : C.c_ctx[k]; sc[i] = cv / (1.0f + __expf(-cv)); }
        __syncthreads();
        for (int cb = C.bx; cb < 256; cb += C.G) {
            if (tid < 504) { const int jc = tid % 36, kg = tid / 36, j = 36 * cb + jc; float a0 = 0.f, a1 = 0.f, a2 = 0.f;
                for (int k = kg; k < 1024; k += 14) { const float w = C.w_ada[(size_t)k * 9216 + j]; a0 += sc[k] * w; a1 += sc[1024 + k] * w; a2 += sc[2048 + k] * w; }
                part[(kg * 3 + 0) * 36 + jc] = a0; part[(kg * 3 + 1) * 36 + jc] = a1; part[(kg * 3 + 2) * 36 + jc] = a2; }
            __syncthreads();
            if (tid < 108) { const int v = tid / 36, jc = tid % 36; float s = 0.f;
                for (int kg = 0; kg < 14; ++kg) s += part[(kg * 3 + v) * 36 + jc];
                C.MOD[v * 9216 + 36 * cb + jc] = s + C.b_ada[36 * cb + jc]; }
            __syncthreads();
        }
    }
    { const int gt = C.bx * 512 + tid; if (gt < 2048) { const int p = gt >> 4, f = gt & 15; const float inv = powf(10000.0f, -(float)f / 16.0f); const float ang = (float)p * inv;
        C.ROPE[2 * gt] = cosf(ang); C.ROPE[2 * gt + 1] = sinf(ang); } }
    LAS float* scr = (LAS float*)(lds + C.wave * 16384);
    const int gw = C.bx * NWAVES + C.wave, NGW = C.G * NWAVES;
    constexpr int I13 = 16 * 176, I2 = 44 * 32, IIN = 16 * 88, IOUT = 16 * 32, NITEMS = 2 * I13 + 2 * I2 + IIN + IOUT;
    for (int it = gw; it < NITEMS; it += NGW) {
        int r = it;
        if (r < 2 * I13) { const int l = r / I13, q = r % I13, kb = q / 176, nb = q % 176, c0 = 32 * nb;
            const int dst = c0 < DFF ? 256 * (c0 / 128) + (c0 % 128) : 256 * ((c0 - DFF) / 128) + 128 + ((c0 - DFF) % 128);
            tr_item(C.w13 + (size_t)l * 1024 * 5632, 5632, c0, 64 * kb, l ? C.W13B : C.W13A, 1024, dst, scr, C.lane); continue; }
        r -= 2 * I13;
        if (r < 2 * I2) { const int l = r / I2, q = r % I2, kb = q / 32, nb = q % 32;
            tr_item(C.w2 + (size_t)l * 2816 * 1024, 1024, 32 * nb, 64 * kb, l ? C.W2B : C.W2A, 2816, 32 * nb, scr, C.lane); continue; }
        r -= 2 * I2;
        if (r < IIN) { const int kb = r / 88, nb = r % 88, n0 = 32 * nb; const int src = n0 < 2048 ? n0 : n0 + 16;
            tr_item(C.w_in, 2832, src, 64 * kb, C.WIN, 1024, n0, scr, C.lane); continue; }
        r -= IIN;
        { const int kb = r / 32, nb = r % 32; tr_item(C.w_out, 1024, 32 * nb, 64 * kb, C.WOUT, 1024, 32 * nb, scr, C.lane); }
    }
}

constexpr int RPW = 4;
__device__ __forceinline__ void p1_modulate(const Ctx& C) {
    const int gw = C.bx * NWAVES + C.wave, NGW = C.G * NWAVES, lane = C.lane;
    for (int r0 = gw * RPW; r0 < MT; r0 += NGW * RPW) {
        const float* src = r0 < ML ? C.x + (size_t)r0 * 1024 : C.ctx + (size_t)(r0 - ML) * 1024;
        const int vb = r0 < SEQ ? 0 : (r0 < ML ? 1 : 2); const float* mv = C.MOD + vb * 9216;
        f32x4 v[RPW][4];
#pragma unroll
        for (int i = 0; i < RPW; ++i)
#pragma unroll
            for (int j = 0; j < 4; ++j) v[i][j] = *(const f32x4*)(src + (size_t)i * 1024 + 4 * lane + 256 * j);
#pragma unroll
        for (int j = 0; j < 4; ++j) { const int c = 4 * lane + 256 * j; const f32x4 sh = *(const f32x4*)(mv + c), sc = *(const f32x4*)(mv + 1024 + c) + 1.0f;
#pragma unroll
            for (int i = 0; i < RPW; ++i) { const f32x4 h = v[i][j] * sc + sh; v2u o; o.x = pk2(h.x, h.y); o.y = pk2(h.z, h.w); *(v2u*)(C.H + (size_t)(r0 + i) * 1024 + c) = o; } }
    }
}

template <bool WRITE_H, bool GATES>
__device__ __forceinline__ void ln_phase(const Ctx& C, LAS unsigned char* lds, const float* src_lat, const float* src_ctx, float* dst_lat, float* dst_ctx, int nrows, int li, int shi, int sci) {
    const int gw = C.bx * NWAVES + C.wave, NGW = C.G * NWAVES, lane = C.lane;
    LAS float* WG = (LAS float*)lds;
    if (GATES) { for (int i = C.tid; i < 16384; i += 512) { const int k = i >> 4, gi = i & 15; WG[gi * 1024 + k] = C.w_in[(size_t)k * 2832 + 2048 + gi]; } __syncthreads(); }
    const float* lg = C.ln_g + li * 1024; const float* lb = C.ln_b + li * 1024;
    for (int r0 = gw * RPW; r0 < nrows; r0 += NGW * RPW) {
        const float* s = r0 < ML ? src_lat + (size_t)r0 * 1024 : src_ctx + (size_t)(r0 - ML) * 1024;
        float* d = r0 < ML ? dst_lat + (size_t)r0 * 1024 : dst_ctx + (size_t)(r0 - ML) * 1024;
        const int vb = r0 < SEQ ? 0 : (r0 < ML ? 1 : 2); const float* mv = C.MOD + vb * 9216;
        f32x4 v[RPW][4]; float sm[RPW], s2[RPW], rstd[RPW];
#pragma unroll
        for (int i = 0; i < RPW; ++i)
#pragma unroll
            for (int j = 0; j < 4; ++j) v[i][j] = *(const f32x4*)(s + (size_t)i * 1024 + 4 * lane + 256 * j);
#pragma unroll
        for (int i = 0; i < RPW; ++i) { sm[i] = 0.f;
#pragma unroll
            for (int j = 0; j < 4; ++j) sm[i] += (v[i][j].x + v[i][j].y) + (v[i][j].z + v[i][j].w); }
#pragma unroll
        for (int o = 1; o < 64; o <<= 1)
#pragma unroll
            for (int i = 0; i < RPW; ++i) sm[i] += __shfl_xor(sm[i], o);
#pragma unroll
        for (int i = 0; i < RPW; ++i) { const float mean = sm[i] * (1.0f / 1024.0f); s2[i] = 0.f;
#pragma unroll
            for (int j = 0; j < 4; ++j) { v[i][j] = v[i][j] - mean; s2[i] += (v[i][j].x * v[i][j].x + v[i][j].y * v[i][j].y) + (v[i][j].z * v[i][j].z + v[i][j].w * v[i][j].w); } }
#pragma unroll
        for (int o = 1; o < 64; o <<= 1)
#pragma unroll
            for (int i = 0; i < RPW; ++i) s2[i] += __shfl_xor(s2[i], o);
#pragma unroll
        for (int i = 0; i < RPW; ++i) rstd[i] = 1.0f / sqrtf(s2[i] * (1.0f / 1024.0f) + LN_EPS);
#pragma unroll
        for (int j = 0; j < 4; ++j) { const int c = 4 * lane + 256 * j; const f32x4 g = *(const f32x4*)(lg + c), b = *(const f32x4*)(lb + c);
            f32x4 sh = {0.f, 0.f, 0.f, 0.f}, sc = {1.f, 1.f, 1.f, 1.f};
            if (WRITE_H) { sh = *(const f32x4*)(mv + shi * 1024 + c); sc = *(const f32x4*)(mv + sci * 1024 + c) + 1.0f; }
#pragma unroll
            for (int i = 0; i < RPW; ++i) { const f32x4 xn = v[i][j] * rstd[i] * g + b; *(f32x4*)(d + (size_t)i * 1024 + c) = xn;
                if (WRITE_H) { const f32x4 h = xn * sc + sh; v[i][j] = h; v2u o; o.x = pk2(h.x, h.y); o.y = pk2(h.z, h.w); *(v2u*)(C.H + (size_t)(r0 + i) * 1024 + c) = o; } } }
        if (GATES) {
#pragma unroll 2
            for (int gi = 0; gi < 16; ++gi) { float a[RPW];
#pragma unroll
                for (int i = 0; i < RPW; ++i) a[i] = 0.f;
#pragma unroll
                for (int j = 0; j < 4; ++j) { const f32x4 w = *(const LAS f32x4*)(WG + gi * 1024 + 4 * lane + 256 * j);
#pragma unroll
                    for (int i = 0; i < RPW; ++i) a[i] += (v[i][j].x * w.x + v[i][j].y * w.y) + (v[i][j].z * w.z + v[i][j].w * w.w); }
#pragma unroll
                for (int o = 1; o < 64; o <<= 1)
#pragma unroll
                    for (int i = 0; i < RPW; ++i) a[i] += __shfl_xor(a[i], o);
                if (lane < RPW) { float av = a[0];
#pragma unroll
                    for (int i = 1; i < RPW; ++i) av = (lane == i) ? a[i] : av;
                    C.GATES[(size_t)(r0 + lane) * 16 + gi] = av + C.b_gates[gi]; } }
        }
    }
    if (GATES) __syncthreads();
}

__device__ __forceinline__ void conv8(const bf16* P, size_t seqrow0, int T, int tpos, int col, const float* conv_w, const float* conv_b, int cch, float (&o)[8]) {
    const f32x4 b0 = *(const f32x4*)(conv_b + cch), b1 = *(const f32x4*)(conv_b + cch + 4);
    float a[8] = {b0.x, b0.y, b0.z, b0.w, b1.x, b1.y, b1.z, b1.w};
#pragma unroll
    for (int j = 0; j < 5; ++j) { const int tp = tpos + j - 2;
        if (tp >= 0 && tp < T) { const v4u raw = *(const v4u*)(P + (seqrow0 + tp) * NP + col);
            const f32x4 w0 = *(const f32x4*)(conv_w + j * 1024 + cch), w1 = *(const f32x4*)(conv_w + j * 1024 + cch + 4);
            a[0] += bflo(raw.x) * w0.x; a[1] += bfhi(raw.x) * w0.y; a[2] += bflo(raw.y) * w0.z; a[3] += bfhi(raw.y) * w0.w;
            a[4] += bflo(raw.z) * w1.x; a[5] += bfhi(raw.z) * w1.y; a[6] += bflo(raw.w) * w1.z; a[7] += bfhi(raw.w) * w1.w; } }
#pragma unroll
    for (int e = 0; e < 8; ++e) o[e] = a[e] * sigmoid_f(a[e]);
}
__device__ __forceinline__ float pre_sum(float v, int lane) {
#pragma unroll
    for (int o = 1; o < 64; o <<= 1) { const float t = __shfl_up(v, o); if (lane >= o) v += t; }
    return v;
}
__device__ __forceinline__ float suf_sum(float v, int lane) {
#pragma unroll
    for (int o = 1; o < 64; o <<= 1) { const float t = __shfl_down(v, o); if (lane + o < 64) v += t; }
    return v;
}
__device__ __forceinline__ float pre_max(float v, int lane) {
#pragma unroll
    for (int o = 1; o < 64; o <<= 1) { const float t = __shfl_up(v, o); if (lane >= o) v = fmaxf(v, t); }
    return v;
}
__device__ __forceinline__ float suf_max(float v, int lane) {
#pragma unroll
    for (int o = 1; o < 64; o <<= 1) { const float t = __shfl_down(v, o); if (lane + o < 64) v = fmaxf(v, t); }
    return v;
}
__device__ __forceinline__ void unit_decode(int u, int& b, int& h, int& c, size_t& seqrow0, int& T) {
    if (u < NUNIT_L) { b = u >> 9; h = (u >> 7) & 3; c = u & 127; seqrow0 = (size_t)b * SEQ; T = SEQ; }
    else { const int uu = u - NUNIT_L; b = uu >> 4; h = (uu >> 2) & 3; c = uu & 3; seqrow0 = (size_t)ML + (size_t)b * CTXL; T = CTXL; }
}

__device__ __forceinline__ void mlstm_local_unit(const Ctx& C, LAS unsigned char* lds, int u) {
    const int tid = C.tid, lane = C.lane, wid = C.wave, fr = lane & 15, fq = lane >> 4;
    int b, h, c, T; size_t seqrow0; unit_decode(u, b, h, c, seqrow0, T);
    const int t0 = 64 * c; const size_t r0 = seqrow0 + t0;
    LAS bf16* KT = (LAS bf16*)lds;
    LAS bf16* VTf = (LAS bf16*)(lds + 18432);
    LAS bf16* VTb = (LAS bf16*)(lds + 36864);
    LAS float* wf = (LAS float*)(lds + 55296);
    LAS float* wb = wf + 64;
    if (wid == 0) {
        const float* G = C.GATES + (r0 + lane) * 16;
        const float li_f = G[h], lf_f = logsig(G[4 + h]), li_b = G[8 + h], lf_b = logsig(G[12 + h]);
        const float b_f = pre_sum(lf_f, lane), b_b = suf_sum(lf_b, lane);
        const float Bf = __shfl(b_f, 63), Bb = __shfl(b_b, 0);
        const float lwf = Bf - b_f + li_f, lwb = Bb - b_b + li_b;
        const float af = wave_max(lwf), ab = wave_max(lwb);
        wf[lane] = __expf(lwf - af); wb[lane] = __expf(lwb - ab);
        if (lane == 0) { C.SC[(u * 2 + 0) * 2 + 0] = Bf; C.SC[(u * 2 + 0) * 2 + 1] = af; C.SC[(u * 2 + 1) * 2 + 0] = Bb; C.SC[(u * 2 + 1) * 2 + 1] = ab; }
    }
    const int chg = tid & 15, tt = tid >> 4;
#pragma unroll
    for (int q = 0; q < 2; ++q) { const int t = tt + 32 * q; float o[8];
        conv8(C.P, seqrow0, T, t0 + t, COL_KM + h * 128 + 8 * chg, C.conv_w, C.conv_b, 512 + h * 128 + 8 * chg, o);
#pragma unroll
        for (int e = 0; e < 8; ++e) KT[(8 * chg + e) * 72 + t] = (bf16)(pk2(o[e], 0.f) & 0xffffu); }
    __syncthreads();
#pragma unroll
    for (int q = 0; q < 2; ++q) { const int t = tt + 32 * q; const v4u raw = *(const v4u*)(C.P + (r0 + t) * NP + COL_VM + h * 128 + 8 * chg);
        const float a = wf[t], bw = wb[t];
        const float v[8] = {bflo(raw.x), bfhi(raw.x), bflo(raw.y), bfhi(raw.y), bflo(raw.z), bfhi(raw.z), bflo(raw.w), bfhi(raw.w)};
#pragma unroll
        for (int e = 0; e < 8; ++e) { VTf[(8 * chg + e) * 72 + t] = (bf16)(pk2(v[e] * a, 0.f) & 0xffffu); VTb[(8 * chg + e) * 72 + t] = (bf16)(pk2(v[e] * bw, 0.f) & 0xffffu); } }
    __syncthreads();
#pragma unroll
    for (int dir = 0; dir < 2; ++dir) { const LAS bf16* VTx = dir ? VTb : VTf;
        const bf16x8 vb0 = *(const LAS bf16x8*)(VTx + (16 * wid + fr) * 72 + 8 * fq), vb1 = *(const LAS bf16x8*)(VTx + (16 * wid + fr) * 72 + 32 + 8 * fq);
        bf16* Ud = C.US + ((size_t)(u * 2 + dir) * 16384) + (16 * wid + fr) * 128 + 4 * fq;
#pragma unroll
        for (int kt = 0; kt < 8; ++kt) { const bf16x8 ka0 = *(const LAS bf16x8*)(KT + (16 * kt + fr) * 72 + 8 * fq), ka1 = *(const LAS bf16x8*)(KT + (16 * kt + fr) * 72 + 32 + 8 * fq);
            f32x4 acc = {0.f, 0.f, 0.f, 0.f};
            acc = __builtin_amdgcn_mfma_f32_16x16x32_bf16(ka0, vb0, acc, 0, 0, 0); acc = __builtin_amdgcn_mfma_f32_16x16x32_bf16(ka1, vb1, acc, 0, 0, 0);
            v2u o; o.x = pk2(acc[0], acc[1]); o.y = pk2(acc[2], acc[3]); *(v2u*)(Ud + 16 * kt) = o; } }
    if (tid < 256) { const int k = tid & 127, dir = tid >> 7; const LAS float* w = dir ? wb : wf; float s = 0.f;
#pragma unroll 8
        for (int t = 0; t < 64; ++t) s += w[t] * bf1(KT[k * 72 + t]);
        C.NU[(size_t)(u * 2 + dir) * 128 + k] = s; }
    __syncthreads();
}

__device__ __forceinline__ int chain_unit(int bh, int dir, int i) {
    if (i < 4) return NUNIT_L + bh * 4 + (dir ? 3 - i : i);
    return bh * 128 + (dir ? 127 - (i - 4) : (i - 4));
}
template <bool ISN> __device__ __forceinline__ f32x4 scan_ld(const Ctx& C, int ud, int eoff) {
    if (ISN) return *(const f32x4*)(C.NU + (size_t)ud * 128 + eoff);
    const v2u raw = *(const v2u*)(C.US + (size_t)ud * 16384 + eoff); return (f32x4){bflo(raw.x), bfhi(raw.x), bflo(raw.y), bfhi(raw.y)};
}
template <bool ISN> __device__ __forceinline__ void scan_st(const Ctx& C, int ud, int eoff, f32x4 v) {
    if (ISN) { *(f32x4*)(C.NU + (size_t)ud * 128 + eoff) = v; }
    else { v2u w; w.x = pk2(v.x, v.y); w.y = pk2(v.z, v.w); *(v2u*)(C.US + (size_t)ud * 16384 + eoff) = w; }
}
template <bool ISN> __device__ __forceinline__ void scan_chain(const Ctx& C, int bh, int dir, int eoff) {
    float m = 0.f; f32x4 st = {0.f, 0.f, 0.f, 0.f};
    f32x4 c4[4];
#pragma unroll
    for (int i = 0; i < 4; ++i) c4[i] = scan_ld<ISN>(C, chain_unit(bh, dir, i) * 2 + dir, eoff);
    f32x4 nx[8];
#pragma unroll
    for (int q = 0; q < 8; ++q) nx[q] = scan_ld<ISN>(C, chain_unit(bh, dir, 4 + q) * 2 + dir, eoff);
#pragma unroll
    for (int i = 0; i < 4; ++i) { const int ud = chain_unit(bh, dir, i) * 2 + dir; const float Bt = C.SC[ud * 2], a = C.SC[ud * 2 + 1];
        const float mn = fmaxf(Bt + m, a), d1 = __expf(Bt + m - mn), d2 = __expf(a - mn); st = st * d1 + c4[i] * d2; m = mn; }
    for (int i0 = 4; i0 < 132; i0 += 8) {
        f32x4 cur[8];
#pragma unroll
        for (int q = 0; q < 8; ++q) cur[q] = nx[q];
        if (i0 + 8 < 132) {
#pragma unroll
            for (int q = 0; q < 8; ++q) nx[q] = scan_ld<ISN>(C, chain_unit(bh, dir, i0 + 8 + q) * 2 + dir, eoff);
        }
#pragma unroll
        for (int q = 0; q < 8; ++q) { const int ud = chain_unit(bh, dir, i0 + q) * 2 + dir; const float Bt = C.SC[ud * 2], a = C.SC[ud * 2 + 1];
            scan_st<ISN>(C, ud, eoff, st);
            if (ISN && eoff == 0) C.MS[ud] = m;
            const float mn = fmaxf(Bt + m, a), d1 = __expf(Bt + m - mn), d2 = __expf(a - mn); st = st * d1 + cur[q] * d2; m = mn; }
    }
}
__device__ __forceinline__ void p7_scan(const Ctx& C) {
    const int tid = C.tid;
    if (C.bx < 128) { const int g = C.bx * 512 + tid, ch = g >> 12, e4 = g & 4095; scan_chain<false>(C, ch >> 1, ch & 1, 4 * e4); }
    else if (C.bx == 128) { const int ch = tid >> 5, k4 = tid & 31; scan_chain<true>(C, ch >> 1, ch & 1, 4 * k4); }
}

__device__ __forceinline__ void mlstm_out_unit(const Ctx& C, LAS unsigned char* lds, int u) {
    const int tid = C.tid, lane = C.lane, wid = C.wave, fr = lane & 15, fq = lane >> 4;
    const int b = u >> 9, h = (u >> 7) & 3, c = u & 127; const size_t seqrow0 = (size_t)b * SEQ; const int t0 = 64 * c; const size_t r0 = seqrow0 + t0;
    LAS bf16* Qs = (LAS bf16*)lds;
    LAS bf16* Ks = (LAS bf16*)(lds + 17408);
    LAS bf16* VT = (LAS bf16*)(lds + 34816);
    LAS bf16* Cs = (LAS bf16*)(lds + 53248);
    LAS bf16* Ss = (LAS bf16*)(lds + 88064);
    LAS float* Hs = (LAS float*)(lds + 97280);
    LAS float* sm = (LAS float*)(lds + 131072);
    LAS float* gA = sm;
    LAS float* MA = sm + 128;
    LAS float* IA = sm + 256;
    LAS float* FA = sm + 384;
    LAS float* DP = sm + 512;
    LAS float* DN = sm + 640;
    LAS float* NS = sm + 704;
    if (wid == 0) {
        const float* G = C.GATES + (r0 + lane) * 16;
        const float li_f = G[h], lf_f = logsig(G[4 + h]), li_b = G[8 + h], lf_b = logsig(G[12 + h]);
        const float b_f = pre_sum(lf_f, lane), b_b = suf_sum(lf_b, lane);
        const float g_f = li_f - b_f, g_b = li_b - b_b;
        const float m_f = C.MS[u * 2 + 0], m_b = C.MS[u * 2 + 1];
        const float M_f = fmaxf(m_f, pre_max(g_f, lane)), M_b = fmaxf(m_b, suf_max(g_b, lane));
        gA[lane] = g_f; gA[64 + lane] = g_b; MA[lane] = M_f; MA[64 + lane] = M_b;
        IA[lane] = __expf(m_f - M_f); IA[64 + lane] = __expf(m_b - M_b);
        FA[lane] = __expf(-(b_f + M_f)); FA[64 + lane] = __expf(-(b_b + M_b));
    }
    const int chg = tid & 15, tt = tid >> 4;
#pragma unroll
    for (int q = 0; q < 2; ++q) { const int t = tt + 32 * q; float o[8];
        conv8(C.P, seqrow0, SEQ, t0 + t, COL_QM + h * 128 + 8 * chg, C.conv_w, C.conv_b, h * 128 + 8 * chg, o);
        const float qs = 0.08838834764831845f;
        v4u w; w.x = pk2(o[0] * qs, o[1] * qs); w.y = pk2(o[2] * qs, o[3] * qs); w.z = pk2(o[4] * qs, o[5] * qs); w.w = pk2(o[6] * qs, o[7] * qs);
        *(LAS v4u*)(Qs + t * 136 + 8 * chg) = w;
        conv8(C.P, seqrow0, SEQ, t0 + t, COL_KM + h * 128 + 8 * chg, C.conv_w, C.conv_b, 512 + h * 128 + 8 * chg, o);
        w.x = pk2(o[0], o[1]); w.y = pk2(o[2], o[3]); w.z = pk2(o[4], o[5]); w.w = pk2(o[6], o[7]);
        *(LAS v4u*)(Ks + t * 136 + 8 * chg) = w;
        const v4u raw = *(const v4u*)(C.P + (r0 + t) * NP + COL_VM + h * 128 + 8 * chg);
        VT[(8 * chg + 0) * 72 + t] = (bf16)(raw.x & 0xffffu); VT[(8 * chg + 1) * 72 + t] = (bf16)(raw.x >> 16);
        VT[(8 * chg + 2) * 72 + t] = (bf16)(raw.y & 0xffffu); VT[(8 * chg + 3) * 72 + t] = (bf16)(raw.y >> 16);
        VT[(8 * chg + 4) * 72 + t] = (bf16)(raw.z & 0xffffu); VT[(8 * chg + 5) * 72 + t] = (bf16)(raw.z >> 16);
        VT[(8 * chg + 6) * 72 + t] = (bf16)(raw.w & 0xffffu); VT[(8 * chg + 7) * 72 + t] = (bf16)(raw.w >> 16); }
    __syncthreads();
    const int tm = wid & 3, sh = wid >> 2;
    f32x4 S[2];
#pragma unroll
    for (int st = 0; st < 2; ++st) { f32x4 acc = {0.f, 0.f, 0.f, 0.f};
#pragma unroll
        for (int ks = 0; ks < 4; ++ks) { const bf16x8 a = *(const LAS bf16x8*)(Qs + (16 * tm + fr) * 136 + 32 * ks + 8 * fq), bb = *(const LAS bf16x8*)(Ks + (32 * sh + 16 * st + fr) * 136 + 32 * ks + 8 * fq);
            acc = __builtin_amdgcn_mfma_f32_16x16x32_bf16(a, bb, acc, 0, 0, 0); }
        S[st] = acc; }
    const int vh = wid >> 2;
    f32x4 hacc[4];
#pragma unroll
    for (int vt = 0; vt < 4; ++vt) hacc[vt] = (f32x4){0.f, 0.f, 0.f, 0.f};
    for (int dir = 0; dir < 2; ++dir) {
        { const bf16* src = C.US + (size_t)(u * 2 + dir) * 16384;
#pragma unroll
            for (int q = 0; q < 4; ++q) { const int idx = tid + 512 * q; const int v = idx >> 4, k8 = idx & 15; *(LAS v4u*)(Cs + v * 136 + 8 * k8) = *(const v4u*)(src + v * 128 + 8 * k8); }
            if (tid < 128) NS[tid] = C.NU[(size_t)(u * 2 + dir) * 128 + tid]; }
        { float rs[4] = {0.f, 0.f, 0.f, 0.f};
#pragma unroll
            for (int st = 0; st < 2; ++st) { const int s = 32 * sh + 16 * st + fr; const float gs = gA[dir * 64 + s];
#pragma unroll
                for (int i = 0; i < 4; ++i) { const int t = 16 * tm + 4 * fq + i; const bool ok = dir ? (s >= t) : (s <= t);
                    const float val = ok ? S[st][i] * __expf(gs - MA[dir * 64 + t]) : 0.f; rs[i] += val; Ss[t * 72 + s] = (bf16)(pk2(val, 0.f) & 0xffffu); } }
#pragma unroll
            for (int i = 0; i < 4; ++i) { float r = rs[i]; r += __shfl_xor(r, 1); r += __shfl_xor(r, 2); r += __shfl_xor(r, 4); r += __shfl_xor(r, 8); if (fr == 0) DP[sh * 64 + 16 * tm + 4 * fq + i] = r; } }
        __syncthreads();
        f32x4 accA[4], accB[4];
#pragma unroll
        for (int vt = 0; vt < 4; ++vt) { accA[vt] = (f32x4){0.f, 0.f, 0.f, 0.f}; accB[vt] = (f32x4){0.f, 0.f, 0.f, 0.f}; }
#pragma unroll
        for (int ks = 0; ks < 2; ++ks) { const bf16x8 a = *(const LAS bf16x8*)(Ss + (16 * tm + fr) * 72 + 32 * ks + 8 * fq);
#pragma unroll
            for (int vt = 0; vt < 4; ++vt) { const bf16x8 bb = *(const LAS bf16x8*)(VT + (64 * vh + 16 * vt + fr) * 72 + 32 * ks + 8 * fq); accA[vt] = __builtin_amdgcn_mfma_f32_16x16x32_bf16(a, bb, accA[vt], 0, 0, 0); } }
#pragma unroll
        for (int ks = 0; ks < 4; ++ks) { const bf16x8 a = *(const LAS bf16x8*)(Qs + (16 * tm + fr) * 136 + 32 * ks + 8 * fq);
#pragma unroll
            for (int vt = 0; vt < 4; ++vt) { const bf16x8 bb = *(const LAS bf16x8*)(Cs + (64 * vh + 16 * vt + fr) * 136 + 32 * ks + 8 * fq); accB[vt] = __builtin_amdgcn_mfma_f32_16x16x32_bf16(a, bb, accB[vt], 0, 0, 0); } }
        { const int t = tid >> 3, part = tid & 7; float d = 0.f;
#pragma unroll
            for (int e = 0; e < 16; ++e) d += bf1(Qs[t * 136 + 16 * part + e]) * NS[16 * part + e];
            d += __shfl_xor(d, 1); d += __shfl_xor(d, 2); d += __shfl_xor(d, 4);
            if (part == 0) { const float den = DP[t] + DP[64 + t] + IA[dir * 64 + t] * d; DN[t] = 1.0f / fmaxf(fabsf(den), FA[dir * 64 + t]); } }
        __syncthreads();
#pragma unroll
        for (int i = 0; i < 4; ++i) { const int t = 16 * tm + 4 * fq + i; const float it = IA[dir * 64 + t], dn = DN[t];
#pragma unroll
            for (int vt = 0; vt < 4; ++vt) hacc[vt][i] += (accA[vt][i] + it * accB[vt][i]) * dn; }
        __syncthreads();
    }
#pragma unroll
    for (int vt = 0; vt < 4; ++vt)
#pragma unroll
        for (int i = 0; i < 4; ++i) Hs[(16 * tm + 4 * fq + i) * 132 + 64 * vh + 16 * vt + fr] = hacc[vt][i];
    __syncthreads();
    { const int t = tid >> 3, part = tid & 7; float hv[16]; float s = 0.f;
#pragma unroll
        for (int e = 0; e < 16; ++e) { hv[e] = Hs[t * 132 + 16 * part + e]; s += hv[e]; }
        s += __shfl_xor(s, 1); s += __shfl_xor(s, 2); s += __shfl_xor(s, 4);
        const float mu = s * (1.0f / 128.0f); float q = 0.f;
#pragma unroll
        for (int e = 0; e < 16; ++e) { hv[e] -= mu; q += hv[e] * hv[e]; }
        q += __shfl_xor(q, 1); q += __shfl_xor(q, 2); q += __shfl_xor(q, 4);
        const float rstd = 1.0f / sqrtf(q * (1.0f / 128.0f) + LN_EPS);
        const bf16* op = C.P + (r0 + t) * NP + COL_OM + h * 128 + 16 * part; const float* gp = C.mh_g + h * 128 + 16 * part;
        const v4u o0 = *(const v4u*)op, o1 = *(const v4u*)(op + 8);
        const float ov[16] = {bflo(o0.x), bfhi(o0.x), bflo(o0.y), bfhi(o0.y), bflo(o0.z), bfhi(o0.z), bflo(o0.w), bfhi(o0.w), bflo(o1.x), bfhi(o1.x), bflo(o1.y), bfhi(o1.y), bflo(o1.z), bfhi(o1.z), bflo(o1.w), bfhi(o1.w)};
        float r[16];
#pragma unroll
        for (int e = 0; e < 16; ++e) r[e] = hv[e] * rstd * gp[e] * sigmoid_f(ov[e]);
        v4u w0, w1; w0.x = pk2(r[0], r[1]); w0.y = pk2(r[2], r[3]); w0.z = pk2(r[4], r[5]); w0.w = pk2(r[6], r[7]); w1.x = pk2(r[8], r[9]); w1.y = pk2(r[10], r[11]); w1.z = pk2(r[12], r[13]); w1.w = pk2(r[14], r[15]);
        bf16* dst = C.H + (r0 + t) * 1024 + h * 128 + 16 * part; *(v4u*)dst = w0; *(v4u*)(dst + 8) = w1; }
    __syncthreads();
}

template <bool MASKED>
__device__ __forceinline__ void attn_chunk(const LAS bf16* Kb  , const LAS bf16* VTb  , int vpitch, const bf16x8 (&qf)[2][2],
                                           f32x4 (&O)[4][2], float (&m)[2], float (&l)[2], int fr, int fq, int rr0  , int iq0  , int pos0  ) {
#pragma unroll
    for (int qt = 0; qt < 2; ++qt) {
        f32x4 S[4];
#pragma unroll
        for (int kt = 0; kt < 4; ++kt) { const bf16x8 kf0 = *(const LAS bf16x8*)(Kb + (16 * kt + fr) * 72 + 8 * fq), kf1 = *(const LAS bf16x8*)(Kb + (16 * kt + fr) * 72 + 32 + 8 * fq);
            f32x4 a = {0.f, 0.f, 0.f, 0.f};
            a = __builtin_amdgcn_mfma_f32_16x16x32_bf16(kf0, qf[qt][0], a, 0, 0, 0); a = __builtin_amdgcn_mfma_f32_16x16x32_bf16(kf1, qf[qt][1], a, 0, 0, 0); S[kt] = a; }
        if (MASKED) {
#pragma unroll
            for (int kt = 0; kt < 4; ++kt)
#pragma unroll
                for (int i = 0; i < 4; ++i) { const int rr = rr0 + 16 * kt + 4 * fq + i, iq = iq0 + 16 * qt, rel = rr - 128 - iq, pos = pos0 + rr;
                    const bool ok = rel >= -128 && rel <= 128 && pos >= 0 && pos < SEQ; if (!ok) S[kt][i] = -INFINITY; }
        }
        float mx = fmaxf(fmaxf(S[0][0], S[0][1]), fmaxf(S[0][2], S[0][3]));
#pragma unroll
        for (int kt = 1; kt < 4; ++kt) mx = fmaxf(mx, fmaxf(fmaxf(S[kt][0], S[kt][1]), fmaxf(S[kt][2], S[kt][3])));
        mx = fmaxf(mx, __shfl_xor(mx, 16)); mx = fmaxf(mx, __shfl_xor(mx, 32));
        const float mn = fmaxf(m[qt], mx), al = __builtin_amdgcn_exp2f(m[qt] - mn); m[qt] = mn; float ps = 0.f;
#pragma unroll
        for (int kt = 0; kt < 4; ++kt)
#pragma unroll
            for (int i = 0; i < 4; ++i) { const float p = __builtin_amdgcn_exp2f(S[kt][i] - mn); S[kt][i] = p; ps += p; }
        l[qt] = l[qt] * al + ps;
#pragma unroll
        for (int dt = 0; dt < 4; ++dt) O[dt][qt] = O[dt][qt] * al;
#pragma unroll
        for (int ks = 0; ks < 2; ++ks) {
            const v4u pw = {pk2(S[2 * ks][0], S[2 * ks][1]), pk2(S[2 * ks][2], S[2 * ks][3]), pk2(S[2 * ks + 1][0], S[2 * ks + 1][1]), pk2(S[2 * ks + 1][2], S[2 * ks + 1][3])};
            const bf16x8 pf = __builtin_bit_cast(bf16x8, pw);
#pragma unroll
            for (int dt = 0; dt < 4; ++dt) { const v2u lo = *(const LAS v2u*)(VTb + (16 * dt + fr) * vpitch + 32 * ks + 4 * fq), hi = *(const LAS v2u*)(VTb + (16 * dt + fr) * vpitch + 32 * ks + 16 + 4 * fq);
                const v4u w = {lo.x, lo.y, hi.x, hi.y}; const bf16x8 vf = __builtin_bit_cast(bf16x8, w);
                O[dt][qt] = __builtin_amdgcn_mfma_f32_16x16x32_bf16(vf, pf, O[dt][qt], 0, 0, 0); }
        }
        __builtin_amdgcn_sched_barrier(0);
    }
}
__device__ __forceinline__ void attn_unit(const Ctx& C, LAS unsigned char* lds, int au) {
    const int tid = C.tid, lane = C.lane, wid = C.wave, fr = lane & 15, fq = lane >> 4;
    const int th = au & 1, j = (au >> 1) & 63, g = (au >> 7) & 1, b = au >> 8;
    LAS bf16* Kl = (LAS bf16*)lds;
    LAS bf16* VTl = (LAS bf16*)(lds + 46080);
    LAS bf16* VTc = (LAS bf16*)(lds + 36864);
    LAS float* RT = (LAS float*)(lds + 88064);
    for (int i = tid; i < 4096; i += 512) RT[i] = C.ROPE[i];
    __syncthreads();
    const int pos0 = (j - 1) * 128;
    for (int task = tid; task < 1280; task += 512) { const int rl = task >> 2, dg = task & 3, d0 = 8 * dg, pos = pos0 + 64 * th + rl;
        v4u o1 = {0u, 0u, 0u, 0u}, o2 = {0u, 0u, 0u, 0u};
        if (pos >= 0 && pos < SEQ) { const bf16* src = C.P + ((size_t)b * SEQ + pos) * NP + COL_KA + g * 64; const v4u x1 = *(const v4u*)(src + d0), x2 = *(const v4u*)(src + 32 + d0);
            const LAS float* rt = (dg < 2) ? RT + ((pos >> 6) * 16 + d0) * 2 : RT + ((pos & 63) * 16 + d0 - 16) * 2;
            const float a[8] = {bflo(x1.x), bfhi(x1.x), bflo(x1.y), bfhi(x1.y), bflo(x1.z), bfhi(x1.z), bflo(x1.w), bfhi(x1.w)};
            const float bb[8] = {bflo(x2.x), bfhi(x2.x), bflo(x2.y), bfhi(x2.y), bflo(x2.z), bfhi(x2.z), bflo(x2.w), bfhi(x2.w)};
            float r1[8], r2[8];
#pragma unroll
            for (int e = 0; e < 8; ++e) { const float cs = rt[2 * e], sn = rt[2 * e + 1]; r1[e] = a[e] * cs - bb[e] * sn; r2[e] = bb[e] * cs + a[e] * sn; }
            o1.x = pk2(r1[0], r1[1]); o1.y = pk2(r1[2], r1[3]); o1.z = pk2(r1[4], r1[5]); o1.w = pk2(r1[6], r1[7]);
            o2.x = pk2(r2[0], r2[1]); o2.y = pk2(r2[2], r2[3]); o2.z = pk2(r2[4], r2[5]); o2.w = pk2(r2[6], r2[7]); }
        *(LAS v4u*)(Kl + rl * 72 + d0) = o1; *(LAS v4u*)(Kl + rl * 72 + 32 + d0) = o2; }
    for (int task = tid; task < 2560; task += 512) { const int rl = task >> 3, dg = task & 7, pos = pos0 + 64 * th + rl; v4u raw = {0u, 0u, 0u, 0u};
        if (pos >= 0 && pos < SEQ) raw = *(const v4u*)(C.P + ((size_t)b * SEQ + pos) * NP + COL_VA + g * 64 + 8 * dg);
        VTl[(8 * dg + 0) * 328 + rl] = (bf16)(raw.x & 0xffffu); VTl[(8 * dg + 1) * 328 + rl] = (bf16)(raw.x >> 16);
        VTl[(8 * dg + 2) * 328 + rl] = (bf16)(raw.y & 0xffffu); VTl[(8 * dg + 3) * 328 + rl] = (bf16)(raw.y >> 16);
        VTl[(8 * dg + 4) * 328 + rl] = (bf16)(raw.z & 0xffffu); VTl[(8 * dg + 5) * 328 + rl] = (bf16)(raw.z >> 16);
        VTl[(8 * dg + 6) * 328 + rl] = (bf16)(raw.w & 0xffffu); VTl[(8 * dg + 7) * 328 + rl] = (bf16)(raw.w >> 16); }
    const int gi = wid >> 1, qs = wid & 1, hq = g * 4 + gi;
    const float QS = 0.125f * LOG2E;
    bf16x8 qf[2][2];
#pragma unroll
    for (int qt = 0; qt < 2; ++qt) { const int iq = 64 * th + 32 * qs + 16 * qt + fr, pos = 128 * j + iq; const bf16* src = C.P + ((size_t)b * SEQ + pos) * NP + COL_QA + hq * 64;
        const v4u x1 = *(const v4u*)(src + 8 * fq), x2 = *(const v4u*)(src + 32 + 8 * fq);
        const LAS float* rt = (fq < 2) ? RT + ((pos >> 6) * 16 + 8 * fq) * 2 : RT + ((pos & 63) * 16 + 8 * fq - 16) * 2;
        const float a[8] = {bflo(x1.x), bfhi(x1.x), bflo(x1.y), bfhi(x1.y), bflo(x1.z), bfhi(x1.z), bflo(x1.w), bfhi(x1.w)};
        const float bb[8] = {bflo(x2.x), bfhi(x2.x), bflo(x2.y), bfhi(x2.y), bflo(x2.z), bfhi(x2.z), bflo(x2.w), bfhi(x2.w)};
        float r1[8], r2[8];
#pragma unroll
        for (int e = 0; e < 8; ++e) { const float cs = rt[2 * e], sn = rt[2 * e + 1]; r1[e] = (a[e] * cs - bb[e] * sn) * QS; r2[e] = (bb[e] * cs + a[e] * sn) * QS; }
        const v4u w1 = {pk2(r1[0], r1[1]), pk2(r1[2], r1[3]), pk2(r1[4], r1[5]), pk2(r1[6], r1[7])}, w2 = {pk2(r2[0], r2[1]), pk2(r2[2], r2[3]), pk2(r2[4], r2[5]), pk2(r2[6], r2[7])};
        qf[qt][0] = __builtin_bit_cast(bf16x8, w1); qf[qt][1] = __builtin_bit_cast(bf16x8, w2); }
    f32x4 O[4][2]; float m[2], l[2];
    const float sinkv = C.sink[hq] * LOG2E;
#pragma unroll
    for (int qt = 0; qt < 2; ++qt) { m[qt] = sinkv; l[qt] = (fq == 0) ? 1.0f : 0.0f;
#pragma unroll
        for (int dt = 0; dt < 4; ++dt) O[dt][qt] = (f32x4){0.f, 0.f, 0.f, 0.f}; }
    __syncthreads();
#pragma unroll 1
    for (int ck = 0; ck < 5; ++ck) {
        const int kp0 = pos0 + 64 * th + 64 * ck; if (kp0 + 63 < 0 || kp0 >= SEQ) continue;
        attn_chunk<true>(Kl + 64 * ck * 72, VTl + 64 * ck, 328, qf, O, m, l, fr, fq, 64 * th + 64 * ck, 64 * th + 32 * qs + fr, pos0);
    }
    __syncthreads();
    for (int task = tid; task < 2048; task += 512) { const int rr = task >> 3, dg = task & 7; const bf16* src = C.P + ((size_t)ML + (size_t)b * CTXL + rr) * NP;
        const v4u kr = *(const v4u*)(src + COL_KA + g * 64 + 8 * dg), raw = *(const v4u*)(src + COL_VA + g * 64 + 8 * dg);
        *(LAS v4u*)(Kl + rr * 72 + 8 * dg) = kr;
        VTc[(8 * dg + 0) * 264 + rr] = (bf16)(raw.x & 0xffffu); VTc[(8 * dg + 1) * 264 + rr] = (bf16)(raw.x >> 16);
        VTc[(8 * dg + 2) * 264 + rr] = (bf16)(raw.y & 0xffffu); VTc[(8 * dg + 3) * 264 + rr] = (bf16)(raw.y >> 16);
        VTc[(8 * dg + 4) * 264 + rr] = (bf16)(raw.z & 0xffffu); VTc[(8 * dg + 5) * 264 + rr] = (bf16)(raw.z >> 16);
        VTc[(8 * dg + 6) * 264 + rr] = (bf16)(raw.w & 0xffffu); VTc[(8 * dg + 7) * 264 + rr] = (bf16)(raw.w >> 16); }
    __syncthreads();
#pragma unroll 1
    for (int ck = 0; ck < 4; ++ck) attn_chunk<false>(Kl + 64 * ck * 72, VTc + 64 * ck, 264, qf, O, m, l, fr, fq, 0, 0, 0);
#pragma unroll
    for (int qt = 0; qt < 2; ++qt) { float lt = l[qt]; lt += __shfl_xor(lt, 16); lt += __shfl_xor(lt, 32); const float inv = 1.0f / lt;
        const int iq = 64 * th + 32 * qs + 16 * qt + fr; bf16* dst = C.H + ((size_t)b * SEQ + 128 * j + iq) * 1024 + 512 + hq * 64 + 4 * fq;
#pragma unroll
        for (int dt = 0; dt < 4; ++dt) { const f32x4 o = O[dt][qt] * inv; v2u w; w.x = pk2(o[0], o[1]); w.y = pk2(o[2], o[3]); *(v2u*)(dst + 16 * dt) = w; } }
    __syncthreads();
}

struct Args { const float* in[17]; float* out; unsigned char* ws; int ph_lo, ph_hi; };
constexpr int N_PHASES = 14;
__global__ void __launch_bounds__(NWAVES * 64, 2) fwd_kernel(Args args) {
    extern __shared__ __attribute__((aligned(16))) unsigned char lds_raw[];
    LAS unsigned char* lds = (LAS unsigned char*)lds_raw;
    cg::grid_group grid = cg::this_grid();
    Ctx C;
    C.x = args.in[0]; C.c = args.in[1]; C.ctx = args.in[2]; C.c_ctx = args.in[3]; C.w_ada = args.in[4]; C.b_ada = args.in[5]; C.ln_g = args.in[6]; C.ln_b = args.in[7];
    C.w13 = args.in[8]; C.w2 = args.in[9]; C.w_in = args.in[10]; C.b_gates = args.in[11]; C.conv_w = args.in[12]; C.conv_b = args.in[13]; C.mh_g = args.in[14]; C.sink = args.in[15]; C.w_out = args.in[16];
    C.out = args.out; C.ws = args.ws;
    unsigned char* ws = args.ws;
    C.MOD = (float*)(ws + WS_MOD); C.ROPE = (float*)(ws + WS_ROPE); C.XC = (float*)(ws + WS_XC); C.GATES = (float*)(ws + WS_GATES); C.NU = (float*)(ws + WS_NU); C.SC = (float*)(ws + WS_SC); C.MS = (float*)(ws + WS_MS);
    C.W13A = (bf16*)(ws + WS_W13A); C.W13B = (bf16*)(ws + WS_W13B); C.W2A = (bf16*)(ws + WS_W2A); C.W2B = (bf16*)(ws + WS_W2B); C.WIN = (bf16*)(ws + WS_WIN); C.WOUT = (bf16*)(ws + WS_WOUT);
    C.H = (bf16*)(ws + WS_H); C.P = (bf16*)(ws + WS_P); C.US = (bf16*)(ws + WS_US);
    C.tid = threadIdx.x; C.lane = C.tid & 63; C.wave = __builtin_amdgcn_readfirstlane(C.tid >> 6); C.G = gridDim.x; C.bx = blockIdx.x;
    const int lo = args.ph_lo, hi = args.ph_hi;
    volatile LAS unsigned* MISC = (volatile LAS unsigned*)(lds + LDS_BYTES - 64);
    if (C.tid < 16) MISC[C.tid] = 0u;
    __syncthreads();
    XcdBarrier xbar; xbar.bar = (unsigned*)(ws + WS_BAR); xbar.x = 0; xbar.st = nullptr;
    if (hi - lo > 1) xbar = xcd_barrier_post((unsigned*)(ws + WS_BAR), MISC + 8);
#ifndef PH_ENABLE
#define PH_ENABLE 0xFFFF
#endif
#define IN(k) ((((PH_ENABLE) >> (k)) & 1) && lo <= (k) && (k) < hi)
#ifndef NO_LOCAL
#define NO_LOCAL 0
#endif
#ifndef NO_ATTN
#define NO_ATTN 0
#endif
#ifndef REPEAT_MASK
#define REPEAT_MASK 0
#endif
#define REP(k) for (int rep_ = 0; rep_ < 1 + (((REPEAT_MASK) >> (k)) & 1); ++rep_)
#define SEAM(k) do { if (IN(k) && IN((k) + 1)) { if ((k) == 0) grid.sync(); else xcd_barrier(xbar); } } while (0)
    typedef pg8::StaticOrder SO;
    if (IN(0)) REP(0) { p0_prologue(C, lds); } SEAM(0);
    if (IN(1)) REP(1) { p1_modulate(C); } SEAM(1);
    if (IN(2)) REP(2) { pg8::Gemm g{C.H, C.W13A, MT, 2 * DFF, DM}; SO S; S.init(MT, 2 * DFF, C.G, C.bx); pg8::EpiSwiglu E{C.P, DFF};
        pg8::gemm_phase<pg8::EpiSwiglu, SO, true, true>(lds, g, S, E); } SEAM(2);
    if (IN(3)) REP(3) { pg8::Gemm g{C.P, C.W2A, MT, DM, DFF}; SO S; S.init(MT, DM, C.G, C.bx); pg8::EpiRes E{C.x, C.ctx, C.out, C.XC, C.MOD, 2, 0.5f, ALPHA_RES};
        pg8::gemm_phase<pg8::EpiRes, SO, true, true>(lds, g, S, E); } SEAM(3);
    if (IN(4)) REP(4) { ln_phase<true, true>(C, lds, C.out, C.XC, C.out, C.XC, MT, 0, 3, 4); } SEAM(4);
    if (IN(5)) REP(5) { pg8::Gemm g{C.H, C.WIN, MT, NP, DM}; SO S; S.init(MT, NP, C.G, C.bx); pg8::EpiBf16<0> E{C.P, NP, nullptr, 0, 0, 1.f};
        pg8::gemm_phase<pg8::EpiBf16<0>, SO, true, true>(lds, g, S, E); } SEAM(5);
    if (IN(6)) REP(6) { if (!NO_LOCAL) for (int u = C.bx; u < NUNIT; u += C.G) mlstm_local_unit(C, lds, u);
        if (!NO_ATTN) for (int au = C.bx; au < 512; au += C.G) attn_unit(C, lds, au); } SEAM(6);
    if (IN(7)) REP(7) { p7_scan(C); } SEAM(7);
    if (IN(8)) REP(8) { for (int u = C.bx; u < NUNIT_L; u += C.G) mlstm_out_unit(C, lds, u); } SEAM(8);
    if (IN(9)) REP(9) { pg8::Gemm g{C.H, C.WOUT, ML, DM, DM}; SO S; S.init(ML, DM, C.G, C.bx); pg8::EpiRes E{C.out, C.XC, C.out, C.XC, C.MOD, 5, 1.0f, ALPHA_RES};
        pg8::gemm_phase<pg8::EpiRes, SO, true, true>(lds, g, S, E); } SEAM(9);
    if (IN(10)) REP(10) { ln_phase<true, false>(C, lds, C.out, C.XC, C.out, C.XC, ML, 1, 6, 7); } SEAM(10);
    if (IN(11)) REP(11) { pg8::Gemm g{C.H, C.W13B, ML, 2 * DFF, DM}; SO S; S.init(ML, 2 * DFF, C.G, C.bx); pg8::EpiSwiglu E{C.P, DFF};
        pg8::gemm_phase<pg8::EpiSwiglu, SO, true, true>(lds, g, S, E); } SEAM(11);
    if (IN(12)) REP(12) { pg8::Gemm g{C.P, C.W2B, ML, DM, DFF}; SO S; S.init(ML, DM, C.G, C.bx); pg8::EpiRes E{C.out, C.XC, C.out, C.XC, C.MOD, 8, 0.5f, ALPHA_RES};
        pg8::gemm_phase<pg8::EpiRes, SO, true, true>(lds, g, S, E); } SEAM(12);
    if (IN(13)) REP(13) { ln_phase<false, false>(C, lds, C.out, C.XC, C.out, C.XC, ML, 2, 0, 0); }
#undef IN
#undef SEAM
}

#ifndef HOST_REPEAT
#define HOST_REPEAT 0
#endif
#ifndef MK_MULTI
#define MK_MULTI 0
#endif
extern "C" void kernel_launch(void* const* d_in, const int* in_sizes, int n_in, void* d_out, int out_size, void* d_ws, size_t ws_size, hipStream_t stream) {
    static int grid = 0;
    if (grid == 0) {
        if (n_in != 17 || out_size != ML * DM || ws_size < WS_END) { fprintf(stderr, "kernel_launch: unexpected problem (n_in %d out %d ws %zu)\n", n_in, out_size, ws_size); grid = -1; return; }
        int dev = 0, cus = 0, per_cu = 0;
        (void)hipGetDevice(&dev); (void)hipDeviceGetAttribute(&cus, hipDeviceAttributeMultiprocessorCount, dev);
        if (hipFuncSetAttribute((const void*)fwd_kernel, hipFuncAttributeMaxDynamicSharedMemorySize, LDS_BYTES) != hipSuccess) { fprintf(stderr, "kernel_launch: hipFuncSetAttribute failed\n"); grid = -1; return; }
        if (hipOccupancyMaxActiveBlocksPerMultiprocessor(&per_cu, (const void*)fwd_kernel, NWAVES * 64, LDS_BYTES) != hipSuccess || per_cu < 1) { per_cu = 1; (void)hipGetLastError(); }
        grid = cus * 1;
        if (grid > 256) grid = 256;
        fprintf(stderr, "kernel_launch: grid %d (cus %d, per_cu %d)\n", grid, cus, per_cu);
    }
    if (grid < 0) return;
    Args a{};
    for (int i = 0; i < 17; ++i) a.in[i] = (const float*)d_in[i];
    a.out = (float*)d_out; a.ws = (unsigned char*)d_ws;
#if MK_MULTI
    for (int p = 0; p < N_PHASES; ++p) for (int rep = 0; rep < 1 + ((HOST_REPEAT >> p) & 1); ++rep) { a.ph_lo = p; a.ph_hi = p + 1; hipLaunchKernelGGL(fwd_kernel, dim3(grid), dim3(NWAVES * 64), LDS_BYTES, stream, a); }
#else
    a.ph_lo = 0; a.ph_hi = N_PHASES;
    (void)hipMemsetAsync((char*)d_ws + WS_BAR, 0, WS_BAR_BYTES, stream);
    void* kargs[] = {&a};
    hipError_t e = hipLaunchCooperativeKernel((const void*)fwd_kernel, dim3(grid), dim3(NWAVES * 64), kargs, LDS_BYTES, stream);
    if (e != hipSuccess) fprintf(stderr, "kernel_launch: cooperative launch failed: %s (grid %d)\n", hipGetErrorString(e), grid);
#endif
}
```
